# Optimizing an MI355X kernel written in HIP

```python
import jax, jax.numpy as jnp
from jax import lax
import numpy as np

D_MODEL = 1024
BATCH = 8
SEQ = 2048
DEPTH = 1
DEC_BATCH = 2
DEC_SEQ = 16384
PAST_LEN = 128

MIX_WIDTH = D_MODEL
POOL_WIDTH = MIX_WIDTH // 4
POOL_WINDOWS = (2, 4, 8, 16)
POOL_GROUPS = len(POOL_WINDOWS)
POOL_GROUP_DIM = POOL_WIDTH // POOL_GROUPS
ATTN_WIDTH = MIX_WIDTH - POOL_WIDTH
HEAD_DIM = 64
N_HEADS = ATTN_WIDTH // HEAD_DIM
DILATED_PATTERNS = ((128, 1), (512, 4), (2048, 16))
BAND_BLOCK = max(w // (2 * d) for w, d in DILATED_PATTERNS)
ROPE_THETA = 500000.0
ROPE_DIM = HEAD_DIM // 4
D_FF = 2816
CONV_WIDTH = 3
EPS = 1e-6
IN_WIDTH = POOL_WIDTH + 3 * ATTN_WIDTH

kernel_name = "hymba_pool_dilated_encoder"


def rmsnorm(x, g):
    xf = x.astype(jnp.float32)
    y = xf * lax.rsqrt(jnp.mean(xf * xf, axis=-1, keepdims=True) + EPS)
    return (y * g.astype(jnp.float32)).astype(x.dtype)


def partial_rope(t, positions):
    inv_freq = ROPE_THETA ** (-jnp.arange(0, ROPE_DIM, 2, dtype=jnp.float32) / ROPE_DIM)
    ang = positions[:, None] * inv_freq[None, :]
    ang = jnp.concatenate([ang, ang], axis=-1)[None, :, None, :]
    cos, sin = jnp.cos(ang), jnp.sin(ang)
    tr, tp = t[..., :ROPE_DIM], t[..., ROPE_DIM:]
    half = ROPE_DIM // 2
    rot = jnp.concatenate([-tr[..., half:], tr[..., :half]], axis=-1)
    return jnp.concatenate([tr * cos + rot * sin, tp], axis=-1)


def pool_mixer(p, pool_w, pool_scale):
    B, S, _ = p.shape
    pg = p.astype(jnp.float32).reshape(B, S, POOL_GROUPS, POOL_GROUP_DIM)
    cs = jnp.concatenate([jnp.zeros_like(pg[:, :1]), jnp.cumsum(pg, axis=1)], axis=1)
    idx = jnp.arange(S)
    outs = []
    for g, w in enumerate(POOL_WINDOWS):
        lo = jnp.clip(idx - w // 2, 0, S)
        hi = jnp.clip(idx + w // 2, 0, S)
        total = cs[:, hi, g] - cs[:, lo, g]
        mean = total / (hi - lo).astype(jnp.float32)[None, :, None]
        outs.append(mean - pg[:, :, g])
    pooled = jnp.stack(outs, axis=2)
    mixed = jnp.einsum('bsgc,gce->bsge', pooled, pool_w.astype(jnp.float32))
    return mixed.reshape(B, S, POOL_WIDTH) * pool_scale.astype(jnp.float32)


def dilated_band_attention(q, k, v, dilation, radius):
    B, S, H, E = q.shape
    L = S // dilation

    def split(t):
        return t.reshape(B, L, dilation, H, E).transpose(0, 2, 3, 1, 4)

    qs, ks, vs = split(q), split(k), split(v)
    nb = -(-L // BAND_BLOCK)
    Lp = nb * BAND_BLOCK
    pad = Lp - L
    qs = jnp.pad(qs, ((0, 0), (0, 0), (0, 0), (0, pad), (0, 0)))
    kpad = ((0, 0), (0, 0), (0, 0), (BAND_BLOCK, pad + BAND_BLOCK), (0, 0))
    ks, vs = jnp.pad(ks, kpad), jnp.pad(vs, kpad)
    qb = qs.reshape(B, dilation, H, nb, BAND_BLOCK, E)

    def neighbours(t):
        tb = t.reshape(B, dilation, H, nb + 2, BAND_BLOCK, E)
        return jnp.concatenate([tb[:, :, :, :-2], tb[:, :, :, 1:-1], tb[:, :, :, 2:]], axis=-2)

    kb, vb = neighbours(ks), neighbours(vs)
    scores = jnp.einsum('bdhnqe,bdhnke->bdhnqk', qb, kb) * (E ** -0.5)
    blk = jnp.arange(nb)[:, None, None]
    qpos = blk * BAND_BLOCK + jnp.arange(BAND_BLOCK)[None, :, None]
    kpos = (blk - 1) * BAND_BLOCK + jnp.arange(3 * BAND_BLOCK)[None, None, :]
    valid = (jnp.abs(qpos - kpos) <= radius) & (kpos >= 0) & (kpos < L)
    scores = jnp.where(valid, scores, -jnp.inf)
    lse = jax.nn.logsumexp(scores, axis=-1)
    probs = jnp.exp(scores - lse[..., None])
    out = jnp.einsum('bdhnqk,bdhnke->bdhnqe', probs, vb)
    out = out.reshape(B, dilation, H, Lp, E)[:, :, :, :L].transpose(0, 3, 1, 2, 4).reshape(B, S, H, E)
    lse = lse.reshape(B, dilation, H, Lp)[..., :L].transpose(0, 3, 1, 2).reshape(B, S, H)
    return out, lse


def dilated_mixture_attention(q, k, v):
    outs, lses = [], []
    for window, dilation in DILATED_PATTERNS:
        o, l = dilated_band_attention(q, k, v, dilation, window // (2 * dilation))
        outs.append(o)
        lses.append(l)
    wts = jax.nn.softmax(jnp.stack(lses, axis=-1), axis=-1)
    return jnp.einsum('bshp,pbshe->bshe', wts, jnp.stack(outs, axis=0))


def encoder_layer(x, g_mix_pre, g_mix_post, w_in, pool_w, pool_scale, g_pool_out, g_attn_out,
                  w_out, g_ffn_pre, g_ffn_post, w_up, conv_w, conv_b, w_down):
    B, S, _ = x.shape
    h = rmsnorm(x, g_mix_pre)
    proj = h @ w_in
    p_in = proj[..., :POOL_WIDTH]
    q = proj[..., POOL_WIDTH:POOL_WIDTH + ATTN_WIDTH]
    k = proj[..., POOL_WIDTH + ATTN_WIDTH:POOL_WIDTH + 2 * ATTN_WIDTH]
    v = proj[..., POOL_WIDTH + 2 * ATTN_WIDTH:]
    pool_out = pool_mixer(p_in, pool_w, pool_scale)
    pos = jnp.arange(S, dtype=jnp.float32)
    q = partial_rope(q.astype(jnp.float32).reshape(B, S, N_HEADS, HEAD_DIM), pos)
    k = partial_rope(k.astype(jnp.float32).reshape(B, S, N_HEADS, HEAD_DIM), pos)
    v = v.astype(jnp.float32).reshape(B, S, N_HEADS, HEAD_DIM)
    attn_out = dilated_mixture_attention(q, k, v).reshape(B, S, ATTN_WIDTH)
    mixed = jnp.concatenate([rmsnorm(pool_out, g_pool_out), rmsnorm(attn_out, g_attn_out)],
                            axis=-1).astype(x.dtype)
    x = x + rmsnorm(mixed @ w_out, g_mix_post)
    h = rmsnorm(x, g_ffn_pre)
    u = h @ w_up
    half = CONV_WIDTH // 2
    up = jnp.pad(u, ((0, 0), (half, half), (0, 0)))
    uc = conv_b
    for j in range(CONV_WIDTH):
        uc = uc + up[:, j:j + S] * conv_w[j]
    gate, val = uc[..., :D_FF], uc[..., D_FF:]
    act = jax.nn.gelu(gate, approximate=False) * val
    x = x + rmsnorm(act @ w_down, g_ffn_post)
    return x


def setup_inputs(seed: int = 0) -> dict:
    key = jax.random.key(seed)
    ks = jax.random.split(key, 16)
    f32 = jnp.float32

    def nrm(k, shape, scale):
        return jax.random.normal(k, shape, f32) * scale

    def gain(k, shape):
        return 1.0 + 0.02 * jax.random.normal(k, shape, f32)

    return {
        "x_prompt": jax.random.normal(ks[0], (BATCH, SEQ, D_MODEL), f32),
        "x_sample": jax.random.normal(ks[1], (DEC_BATCH, DEC_SEQ, D_MODEL), f32),
        "g_mix_pre": gain(ks[2], (DEPTH, D_MODEL)),
        "g_mix_post": gain(ks[3], (DEPTH, D_MODEL)),
        "w_in": nrm(ks[4], (DEPTH, D_MODEL, IN_WIDTH), D_MODEL ** -0.5),
        "pool_w": nrm(ks[5], (DEPTH, POOL_GROUPS, POOL_GROUP_DIM, POOL_GROUP_DIM), POOL_GROUP_DIM ** -0.5),
        "pool_scale": gain(ks[6], (DEPTH, POOL_WIDTH)),
        "g_pool_out": gain(ks[7], (DEPTH, POOL_WIDTH)),
        "g_attn_out": gain(ks[8], (DEPTH, ATTN_WIDTH)),
        "w_out": nrm(ks[9], (DEPTH, MIX_WIDTH, D_MODEL), MIX_WIDTH ** -0.5),
        "g_ffn_pre": gain(ks[10], (DEPTH, D_MODEL)),
        "g_ffn_post": gain(ks[11], (DEPTH, D_MODEL)),
        "w_up": nrm(ks[12], (DEPTH, D_MODEL, 2 * D_FF), D_MODEL ** -0.5),
        "conv_w": nrm(ks[13], (DEPTH, CONV_WIDTH, 2 * D_FF), CONV_WIDTH ** -0.5),
        "conv_b": nrm(ks[14], (DEPTH, 2 * D_FF), 0.02),
        "w_down": nrm(ks[15], (DEPTH, D_FF, D_MODEL), D_FF ** -0.5),
    }


def reference(x_prompt, x_sample, g_mix_pre, g_mix_post, w_in, pool_w, pool_scale, g_pool_out,
              g_attn_out, w_out, g_ffn_pre, g_ffn_post, w_up, conv_w, conv_b, w_down):
    def run(x):
        for l in range(DEPTH):
            x = encoder_layer(x, g_mix_pre[l], g_mix_post[l], w_in[l], pool_w[l], pool_scale[l],
                              g_pool_out[l], g_attn_out[l], w_out[l], g_ffn_pre[l], g_ffn_post[l],
                              w_up[l], conv_w[l], conv_b[l], w_down[l])
        return x

    y_prompt = run(x_prompt)
    y_sample = run(x_sample)
    return (y_prompt, y_sample)
```

```cpp
#include <hip/hip_runtime.h>
#include <hip/hip_cooperative_groups.h>
#include <cstdio>
#include <cstdint>
namespace cg = cooperative_groups;

#ifndef USE_CG_SYNC
#define USE_CG_SYNC 0
#endif

namespace pg8 {
#define PG8_LAS __attribute__((address_space(3)))
typedef unsigned short bf16_t;
typedef short bf16x8 __attribute__((ext_vector_type(8)));
typedef float f32x4 __attribute__((ext_vector_type(4)));
typedef unsigned u32x4 __attribute__((ext_vector_type(4)));
constexpr int BM = 256, BK = 64, HALF = 128, HTB = HALF * BK * 2, STAGE_BYTES = 8 * HTB, NXCD = 8, WGM = 8;

__host__ __device__ __forceinline__ int lds_byte(int r, int c) { const int st = (r >> 4) * 2 + (c >> 5), rr = r & 15, cc = c & 31, ob = rr * 64 + cc * 2; return st * 1024 + (ob ^ (((ob >> 9) & 1) << 5)); }
__host__ __device__ __forceinline__ void stage_rc(int b, int& R, int& C) { const int st = b / 1024, sb = b % 1024, swz = sb ^ (((sb >> 9) & 1) << 5); R = (st >> 1) * 16 + swz / 64; C = (st & 1) * 32 + (swz % 64) / 2; }
__host__ __device__ __forceinline__ int perm32(int rho) { const int n = rho >> 4, i = rho & 15; return 8 * (i >> 2) + 4 * n + (i & 3); }

constexpr int MTOK = 49152, NTOKP = 16384;
constexpr float C2 = 0.125f * 1.4426950408889634f;
struct Unit { int pm, pn; };
struct Gemm { const bf16_t* A; const bf16_t* Bt; int M, N, K; };

struct StaticOrder {
    int nM, nN, nwg, G, c;
    __host__ __device__ void init(int M, int N, int G_, int c_) { nM = M / BM; nN = N / BM; nwg = nM * nN; G = G_; c = c_; }
    __host__ __device__ bool next(int i, Unit& u) const {
        const long L = (long)i * G + c; if (L >= nwg) return false;
        int wgid = (int)L; { const int q = nwg / NXCD, r = nwg % NXCD, xcd = wgid % NXCD, off = wgid / NXCD; wgid = (xcd < r ? xcd * (q + 1) : r * (q + 1) + (xcd - r) * q) + off; }
        const int nig = WGM * nN, gid = wgid / nig, fm = gid * WGM, gsz = (nM - fm) < WGM ? (nM - fm) : WGM;
        u.pm = fm + ((wgid % nig) % gsz); u.pn = (wgid % nig) / gsz; return true;
    }
    __device__ __forceinline__ void a_ready(const Unit&) const {}
    __device__ __forceinline__ void done(const Unit&) const {}
};

__device__ __forceinline__ unsigned cvt_pk_bf16(float lo, float hi) { unsigned r; asm volatile("v_cvt_pk_bf16_f32 %0, %1, %2" : "=v"(r) : "v"(lo), "v"(hi)); return r; }
typedef float f32x2 __attribute__((ext_vector_type(2)));
__device__ __forceinline__ f32x2 gelu_pk(f32x2 v) {
    const f32x2 av = __builtin_elementwise_abs(v), d = av * 0.2316418882f + 1.0f;
    f32x2 t; t.x = __builtin_amdgcn_rcpf(d.x); t.y = __builtin_amdgcn_rcpf(d.y);
    f32x2 q = t * 0.5307027145f + (-0.7265760135f); q = q * t + 0.7107068705f; q = q * t + (-0.142248368f); q = q * t + 0.127414796f; q = q * t;
    const f32x2 s = (v * v) * (-0.72134752044f);
    f32x2 e; e.x = __builtin_amdgcn_exp2f(s.x); e.y = __builtin_amdgcn_exp2f(s.y);
    const f32x2 m = v * (q * e), r = v - m;
    f32x2 o; o.x = v.x < 0.f ? m.x : r.x; o.y = v.y < 0.f ? m.y : r.y; return o;
}

struct EpiStore {
    static constexpr bool PERM = true, AFTER_DRAIN = false; static constexpr bool NEEDS_LDS = false; static __device__ __forceinline__ int row0(int pm) { return pm * BM; } static constexpr int MIDK_T = 0;
    bf16_t* O; int ldc;
    __device__ __forceinline__ void operator()(const f32x4 (&acc)[2][2][4][2], const Unit& u, int wr, int wc, int fr, int fq) const {
        const int lane = fq * 16 + fr, srcl = 16 * (lane & 3) + (lane >> 2), r2 = lane >> 2, c2 = lane & 3;
        const int row0 = u.pm * BM + wr * 64 + r2; const int col0 = u.pn * BM + wc * 32 + 8 * c2;
#pragma unroll
        for (int ai = 0; ai < 2; ++ai)
#pragma unroll
            for (int m = 0; m < 4; ++m) { bf16_t* rowp = O + (size_t)(row0 + ai * HALF + m * 16) * ldc + col0;
#pragma unroll
                for (int bj = 0; bj < 2; ++bj) { const f32x4 v0 = acc[ai][bj][m][0], v1 = acc[ai][bj][m][1];
                    u32x4 w; w.x = __shfl(cvt_pk_bf16(v0[0], v0[1]), srcl); w.y = __shfl(cvt_pk_bf16(v0[2], v0[3]), srcl); w.z = __shfl(cvt_pk_bf16(v1[0], v1[1]), srcl); w.w = __shfl(cvt_pk_bf16(v1[2], v1[3]), srcl);
                    *(u32x4*)(rowp + bj * HALF) = w; } }
    }
};

struct EpiOutProj {
    static constexpr bool PERM = true, AFTER_DRAIN = false; static constexpr bool NEEDS_LDS = false; static __device__ __forceinline__ int row0(int pm) { return pm * BM; } static constexpr int MIDK_T = 4;
    bf16_t* O; int ldc; const float* ssq;
    __device__ __forceinline__ float sattn(int row) const { const f32x4* p = (const f32x4*)(ssq + (size_t)row * 12); const f32x4 a = p[0], b = p[1], c = p[2];
        return sqrtf((((a[0] + a[1]) + (a[2] + a[3])) + ((b[0] + b[1]) + (b[2] + b[3])) + ((c[0] + c[1]) + (c[2] + c[3]))) * (1.f / 768.f) + 1e-6f); }
    __device__ __forceinline__ void midk(f32x4 (&acc)[2][2][4][2], const Unit& u, int wr, int) const {
        int tl = threadIdx.x; asm volatile("" : "+v"(tl));
        const int row0 = u.pm * BM + wr * 64 + (tl & 15);
#pragma unroll
        for (int ai = 0; ai < 2; ++ai)
#pragma unroll
            for (int m = 0; m < 4; ++m) { const float sv = sattn(row0 + ai * HALF + m * 16);
#pragma unroll
                for (int bj = 0; bj < 2; ++bj)
#pragma unroll
                    for (int n = 0; n < 2; ++n) acc[ai][bj][m][n] = acc[ai][bj][m][n] * sv; }
    }
    __device__ __forceinline__ void operator()(const f32x4 (&acc)[2][2][4][2], const Unit& u, int wr, int wc, int fr, int fq) const {
        const int row0 = u.pm * BM + wr * 64 + fr; const int col0 = u.pn * BM + wc * 32 + 8 * fq;
#pragma unroll
        for (int ai = 0; ai < 2; ++ai)
#pragma unroll
            for (int m = 0; m < 4; ++m) { const int row = row0 + ai * HALF + m * 16; const float r = 1.f / sattn(row); bf16_t* rowp = O + (size_t)row * ldc + col0;
#pragma unroll
                for (int bj = 0; bj < 2; ++bj) { const f32x4 v0 = acc[ai][bj][m][0] * r, v1 = acc[ai][bj][m][1] * r;
                    u32x4 w; w.x = cvt_pk_bf16(v0[0], v0[1]); w.y = cvt_pk_bf16(v0[2], v0[3]); w.z = cvt_pk_bf16(v1[0], v1[1]); w.w = cvt_pk_bf16(v1[2], v1[3]);
                    *(u32x4*)(rowp + bj * HALF) = w; } }
    }
};

struct EpiConvGelu {
    static constexpr bool PERM = true, AFTER_DRAIN = false, NEEDS_LDS = true; static constexpr int MIDK_T = 0;
    static constexpr int NTILES = (MTOK + 253) / 254;
    bf16_t* ACT; const float* cw; const float* cb; const float* rs;
    static __device__ __forceinline__ int row0(int pm) { return 254 * pm - 1; }
    __device__ __forceinline__ void run(f32x4 (&acc)[2][2][4][2], const Unit& u, int wr, int wc, PG8_LAS unsigned char* xbuf) const {
        int tl = threadIdx.x; asm volatile("" : "+v"(tl));
        const int lane = tl & 63, fr = lane & 15, fq = lane >> 4;
        const int rb = 254 * u.pm - 1;
        const int colw = 32 * wc + 8 * fq, ch0 = 128 * u.pn + colw;
        PG8_LAS float* X = (PG8_LAS float*)xbuf;
#pragma unroll
        for (int ai = 0; ai < 2; ++ai)
#pragma unroll
            for (int m = 0; m < 4; ++m) { int row = rb + 128 * ai + 64 * wr + 16 * m + fr; row = row < 0 ? 0 : (row > MTOK - 1 ? MTOK - 1 : row); const float rr = rs[row];
#pragma unroll
                for (int bj = 0; bj < 2; ++bj)
#pragma unroll
                    for (int n = 0; n < 2; ++n) acc[ai][bj][m][n] = acc[ai][bj][m][n] * rr; }
#pragma unroll
        for (int ai = 0; ai < 2; ++ai) { const int c = 2 * ai + wr;
#pragma unroll
            for (int bj = 0; bj < 2; ++bj)
#pragma unroll
                for (int n = 0; n < 2; ++n) { const int col = 128 * bj + colw + 4 * n;
                    if (fr == 0) *(PG8_LAS f32x4*)(X + (c * 2 + 0) * 256 + col) = acc[ai][bj][0][n];
                    if (fr == 15) *(PG8_LAS f32x4*)(X + (c * 2 + 1) * 256 + col) = acc[ai][bj][3][n]; } }
        asm volatile("s_waitcnt lgkmcnt(0)" ::: "memory"); __builtin_amdgcn_s_barrier(); asm volatile("" ::: "memory");
        const int lo_ = rb, hi_ = rb + 255, lg_ = hi_ < NTOKP ? 11 : 14;
        const bool hasb = (lo_ < NTOKP && hi_ >= NTOKP) || (((hi_ + 1) >> lg_) >= ((lo_ + (1 << lg_) - 1) >> lg_));
        if (hasb) body<true>(acc, u, wr, wc, X, fr, fq, rb, colw, ch0); else body<false>(acc, u, wr, wc, X, fr, fq, rb, colw, ch0);
    }
    template <bool HASB>
    __device__ __forceinline__ void body(f32x4 (&acc)[2][2][4][2], const Unit& u, int wr, int wc, PG8_LAS float* X, int fr, int fq, int rb, int colw, int ch0) const {
        typedef unsigned u32x2 __attribute__((ext_vector_type(2)));
        u32x2 stash[2][4];
#pragma unroll
        for (int n = 0; n < 2; ++n) {
            f32x4 wg[3], wv[3];
#pragma unroll
            for (int t3 = 0; t3 < 3; ++t3) { wg[t3] = *(const f32x4*)(cw + (size_t)t3 * 5632 + ch0 + 4 * n); wv[t3] = *(const f32x4*)(cw + (size_t)t3 * 5632 + 2816 + ch0 + 4 * n); }
            const f32x4 bg = *(const f32x4*)(cb + ch0 + 4 * n), bv = *(const f32x4*)(cb + 2816 + ch0 + 4 * n);
#pragma unroll
            for (int ai = 0; ai < 2; ++ai) { const int c = 2 * ai + wr;
                f32x4 pr[2], nx[2];
#pragma unroll
                for (int bj = 0; bj < 2; ++bj) { const int col = 128 * bj + colw + 4 * n;
                    pr[bj] = *(const PG8_LAS f32x4*)(X + ((c > 0 ? c - 1 : 0) * 2 + 1) * 256 + col); nx[bj] = *(const PG8_LAS f32x4*)(X + ((c < 3 ? c + 1 : 3) * 2 + 0) * 256 + col); }
#pragma unroll
                for (int m = 0; m < 4; ++m) {
                    const int rt = 128 * ai + 64 * wr + 16 * m + fr, row = rb + rt;
                    const int Sm1 = row < NTOKP ? 2047 : 16383, t = row & Sm1;
                    const bool z_up = t == 0, z_dn = t == Sm1;
                    f32x4 y[2];
#pragma unroll
                    for (int bj = 0; bj < 2; ++bj) { const f32x4 x = acc[ai][bj][m][n];
                        const f32x4 srcu = m > 0 ? acc[ai][bj][m > 0 ? m - 1 : 0][n] : pr[bj], srcd = m < 3 ? acc[ai][bj][m < 3 ? m + 1 : 3][n] : nx[bj];
                        f32x4 up, dn;
#pragma unroll
                        for (int e = 0; e < 4; ++e) { const float su = fr == 15 ? srcu[e] : x[e], sd = fr == 0 ? srcd[e] : x[e];
                            const float gu = __builtin_bit_cast(float, __builtin_amdgcn_update_dpp(0, __builtin_bit_cast(int, su), 0x121, 0xF, 0xF, false));
                            const float gd = __builtin_bit_cast(float, __builtin_amdgcn_update_dpp(0, __builtin_bit_cast(int, sd), 0x12F, 0xF, 0xF, false));
                            up[e] = (HASB && z_up) ? 0.f : gu; dn[e] = (HASB && z_dn) ? 0.f : gd; }
                        y[bj] = bj ? (bv + wv[0] * up + wv[1] * x + wv[2] * dn) : (bg + wg[0] * up + wg[1] * x + wg[2] * dn); }
                    const f32x2 g0 = gelu_pk((f32x2){y[0][0], y[0][1]}), g1 = gelu_pk((f32x2){y[0][2], y[0][3]});
                    u32x2 w; w.x = cvt_pk_bf16(g0.x * y[1][0], g0.y * y[1][1]); w.y = cvt_pk_bf16(g1.x * y[1][2], g1.y * y[1][3]);
                    if (n == 0) stash[ai][m] = w;
                    else if (rt >= 1 && rt <= 254 && row < MTOK) { u32x4 w4; w4.x = stash[ai][m].x; w4.y = stash[ai][m].y; w4.z = w.x; w4.w = w.y; *(u32x4*)(ACT + (size_t)row * 2816 + ch0) = w4; }
                }
            }
        }
    }
};

struct EpiProj {
    static constexpr bool PERM = true, AFTER_DRAIN = false; static constexpr bool NEEDS_LDS = false; static __device__ __forceinline__ int row0(int pm) { return pm * BM; } static constexpr int MIDK_T = 0;
    bf16_t *P, *Q; const float* rope; const float* rs;
    __device__ __forceinline__ void operator()(const f32x4 (&acc)[2][2][4][2], const Unit& u, int wr, int wc, int fr, int fq) const {
        const int row0 = u.pm * BM + wr * 64 + fr;
        if (u.pn == 0) {
            const int col0 = wc * 32 + 8 * fq;
#pragma unroll
            for (int ai = 0; ai < 2; ++ai)
#pragma unroll
                for (int m = 0; m < 4; ++m) { bf16_t* rowp = P + (size_t)(row0 + ai * HALF + m * 16) * 256 + col0; const float rr = rs[row0 + ai * HALF + m * 16];
#pragma unroll
                    for (int bj = 0; bj < 2; ++bj) { const f32x4 v0 = acc[ai][bj][m][0] * rr, v1 = acc[ai][bj][m][1] * rr;
                        u32x4 w; w.x = cvt_pk_bf16(v0[0], v0[1]); w.y = cvt_pk_bf16(v0[2], v0[3]); w.z = cvt_pk_bf16(v1[0], v1[1]); w.w = cvt_pk_bf16(v1[2], v1[3]);
                        *(u32x4*)(rowp + bj * HALF) = w; } }
        } else {
            const int kind = (u.pn - 1) / 3, hb = ((u.pn - 1) % 3) * 4;
            bf16_t* T = Q + (size_t)kind * ((size_t)MTOK * 768);
            const bool do_rope = (kind < 2) && ((wc & 1) == 0);
            const float sc = kind == 0 ? C2 : 1.0f;
            const float sgn = fq == 0 ? -1.0f : 1.0f;
            const int dim0 = 32 * (wc & 1) + 8 * fq;
#pragma unroll
            for (int ai = 0; ai < 2; ++ai)
#pragma unroll
                for (int m = 0; m < 4; ++m) { const int row = row0 + ai * HALF + m * 16; const int t = row < NTOKP ? (row & 2047) : (row & 16383); const float rr = rs[row];
#pragma unroll
                    for (int bj = 0; bj < 2; ++bj) { f32x4 v0 = acc[ai][bj][m][0] * rr, v1 = acc[ai][bj][m][1] * rr;
                        if (do_rope) {
                            f32x4 p0, p1;
#pragma unroll
                            for (int j = 0; j < 4; ++j) {
                                auto a0 = __builtin_amdgcn_permlane16_swap(__float_as_uint(v0[j]), __float_as_uint(v0[j]), false, false);
                                auto a1 = __builtin_amdgcn_permlane16_swap(__float_as_uint(v1[j]), __float_as_uint(v1[j]), false, false);
                                p0[j] = __uint_as_float((fq & 1) ? a0[0] : a0[1]); p1[j] = __uint_as_float((fq & 1) ? a1[0] : a1[1]); }
                            if (fq < 2) { const f32x4 c0 = *(const f32x4*)(rope + t * 16), c1 = *(const f32x4*)(rope + t * 16 + 4), s0 = *(const f32x4*)(rope + t * 16 + 8), s1 = *(const f32x4*)(rope + t * 16 + 12);
                                v0 = v0 * c0 + (p0 * s0) * sgn; v1 = v1 * c1 + (p1 * s1) * sgn; }
                        }
                        v0 = v0 * sc; v1 = v1 * sc;
                        const int head = hb + 2 * bj + (wc >> 1);
                        u32x4 w; w.x = cvt_pk_bf16(v0[0], v0[1]); w.y = cvt_pk_bf16(v0[2], v0[3]); w.z = cvt_pk_bf16(v1[0], v1[1]); w.w = cvt_pk_bf16(v1[2], v1[3]);
                        *(u32x4*)(T + ((size_t)head * MTOK + row) * 64 + dim0) = w; } }
        }
    }
};

template <class Epi, class Sched, bool ALIGN_EPI = false, bool SP2 = false>
__device__ __forceinline__ void gemm_phase(PG8_LAS unsigned char* lds, const Gemm g, const Sched& S, const Epi& E) {
    int tid = threadIdx.x; asm volatile("" : "+v"(tid));
    const int wid = __builtin_amdgcn_readfirstlane(tid >> 6), lane = tid & 63, wr = wid >> 2, wc = wid & 3, fr = lane & 15, fq = lane >> 4;
    const int K = g.K, nt = K / BK;
    unsigned voffA[2], voffB[2];
#pragma unroll
    for (int i = 0; i < 2; ++i) { int R, C; stage_rc(tid * 16 + i * 8192, R, C); const int Rb = Epi::PERM ? ((R & ~31) + perm32(R & 31)) : R;
        voffA[i] = (unsigned)(R * K + C) * 2u; voffB[i] = (unsigned)(Rb * K + C) * 2u; }
    const size_t kstep = (size_t)(BK * 2);
    const size_t hstep = (size_t)HALF * K * 2;
    const size_t tstep = 2 * hstep;
    const unsigned ldsw = (unsigned)wid * 1024u;
    const int aoff = lds_byte(wr * 64 + fr, fq * 8), boff = lds_byte(wc * 32 + fr, fq * 8);
#define PG8_SA(b, h) (((b) * 2 + (h)) * HTB)
#define PG8_SB(b, h) ((4 + (b) * 2 + (h)) * HTB)
#define PG8_STAGE(bufoff, gbase, voff) do { _Pragma("unroll") for (int _i = 0; _i < 2; ++_i) \
        __builtin_amdgcn_global_load_lds((const unsigned*)((const char*)(gbase) + (voff)[_i]), (PG8_LAS unsigned*)(lds + (bufoff) + ldsw + _i * 8192), 16, 0, 0); } while (0)
#define PG8_LDA(dst, b, h) do { _Pragma("unroll") for (int m = 0; m < 4; ++m) _Pragma("unroll") for (int k = 0; k < 2; ++k) dst[m][k] = *(const PG8_LAS bf16x8*)(lds + PG8_SA(b, h) + aoff + m * 2048 + k * 1024); } while (0)
#define PG8_LDB(dst, b, h) do { _Pragma("unroll") for (int n = 0; n < 2; ++n) _Pragma("unroll") for (int k = 0; k < 2; ++k) dst[n][k] = *(const PG8_LAS bf16x8*)(lds + PG8_SB(b, h) + boff + n * 2048 + k * 1024); } while (0)
#define PG8_MMA(ai, bj, At, Bt) do { __builtin_amdgcn_s_setprio(1); _Pragma("unroll") for (int m = 0; m < 4; ++m) _Pragma("unroll") for (int n = 0; n < 2; ++n) _Pragma("unroll") for (int k = 0; k < 2; ++k) \
        acc[ai][bj][m][n] = __builtin_amdgcn_mfma_f32_16x16x32_bf16(Bt[n][k], At[m][k], acc[ai][bj][m][n], 0, 0, 0); __builtin_amdgcn_s_setprio(0); } while (0)
#define PG8_WAIT_V(n) asm volatile("s_waitcnt vmcnt(" #n ")" ::: "memory")
#define PG8_WAIT_L(n) asm volatile("s_waitcnt lgkmcnt(" #n ")" ::: "memory")
#define PG8_BAR __builtin_amdgcn_s_barrier()
#define PG8_SCHED __builtin_amdgcn_sched_barrier(0)
    Unit cur, nxt; int ui = 0;
    if (!S.next(0, cur)) return;
    f32x4 acc[2][2][4][2];
#pragma unroll
    for (int a = 0; a < 2; ++a)
#pragma unroll
        for (int b = 0; b < 2; ++b)
#pragma unroll
            for (int m = 0; m < 4; ++m)
#pragma unroll
                for (int n = 0; n < 2; ++n) acc[a][b][m][n] = (f32x4){0.f, 0.f, 0.f, 0.f};
    bf16x8 At[4][2], B0[2][2], B1[2][2];
    const long rstep = (long)K * 2;
    const char* cA = (const char*)g.A + (long)Epi::row0(cur.pm) * rstep; const char* cB = (const char*)g.Bt + (size_t)cur.pn * tstep;
    S.a_ready(cur);
    if constexpr (SP2) {
        PG8_STAGE(PG8_SB(0, 0), cB, voffB); PG8_STAGE(PG8_SB(0, 1), cB + hstep, voffB); PG8_STAGE(PG8_SA(0, 0), cA, voffA); PG8_STAGE(PG8_SA(0, 1), cA + hstep, voffA);
        if (wr == 1) PG8_BAR;
        PG8_WAIT_V(2); PG8_BAR;
        PG8_STAGE(PG8_SB(1, 0), cB + kstep, voffB); PG8_STAGE(PG8_SA(1, 0), cA + kstep, voffA); PG8_STAGE(PG8_SB(1, 1), cB + hstep + kstep, voffB);
        PG8_WAIT_V(6); PG8_BAR;
    } else {
        PG8_STAGE(PG8_SB(0, 0), cB, voffB); PG8_STAGE(PG8_SA(0, 0), cA, voffA); PG8_STAGE(PG8_SB(0, 1), cB + hstep, voffB); PG8_STAGE(PG8_SA(0, 1), cA + hstep, voffA);
        if (wr == 1) PG8_BAR;
        PG8_WAIT_V(4); PG8_BAR;
        PG8_STAGE(PG8_SB(1, 0), cB + kstep, voffB); PG8_STAGE(PG8_SA(1, 0), cA + kstep, voffA); PG8_STAGE(PG8_SB(1, 1), cB + hstep + kstep, voffB);
        PG8_WAIT_V(6); PG8_BAR;
    }
    for (;;) {
        const bool has_next = S.next(ui + 1, nxt);
        const char* nA = has_next ? (const char*)g.A + (long)Epi::row0(nxt.pm) * rstep : cA; const char* nB = has_next ? (const char*)g.Bt + (size_t)nxt.pn * tstep : cB;
        for (int t = 0; t < nt; t += 2) {
            const bool last = (t == nt - 2);
            const char* a1 = cA + (size_t)(t + 1) * kstep;
            const char* a2 = last ? nA : cA + (size_t)(t + 2) * kstep; const char* b2 = last ? nB : cB + (size_t)(t + 2) * kstep;
            const char* a3 = a2 + kstep; const char* b3 = b2 + kstep;
            if (last && has_next) S.a_ready(nxt);
            if constexpr (Epi::MIDK_T > 0) { if (t == Epi::MIDK_T) E.midk(acc, cur, wr, fr); }
            if constexpr (SP2) {
            PG8_LDB(B0, 0, 0); PG8_LDB(B1, 0, 1); PG8_SCHED; PG8_LDA(At, 0, 0); PG8_STAGE(PG8_SA(1, 1), a1 + hstep, voffA);
            PG8_WAIT_V(8); PG8_WAIT_L(0); PG8_BAR; PG8_MMA(0, 0, At, B0); PG8_MMA(0, 1, At, B1); PG8_BAR; PG8_SCHED;
            PG8_LDA(At, 0, 1); PG8_STAGE(PG8_SB(0, 0), b2, voffB); PG8_STAGE(PG8_SB(0, 1), b2 + hstep, voffB); PG8_STAGE(PG8_SA(0, 0), a2, voffA);
            PG8_WAIT_V(8); PG8_WAIT_L(0); PG8_BAR; PG8_MMA(1, 0, At, B0); PG8_MMA(1, 1, At, B1); PG8_BAR; PG8_SCHED;
            PG8_LDB(B0, 1, 0); PG8_LDB(B1, 1, 1); PG8_SCHED; PG8_LDA(At, 1, 0); PG8_STAGE(PG8_SA(0, 1), a2 + hstep, voffA);
            PG8_WAIT_V(8); PG8_WAIT_L(0); PG8_BAR; PG8_MMA(0, 0, At, B0); PG8_MMA(0, 1, At, B1); PG8_BAR; PG8_SCHED;
            PG8_LDA(At, 1, 1); PG8_STAGE(PG8_SB(1, 0), b3, voffB); PG8_STAGE(PG8_SB(1, 1), b3 + hstep, voffB); PG8_STAGE(PG8_SA(1, 0), a3, voffA);
            PG8_WAIT_V(8); PG8_WAIT_L(0); PG8_BAR; PG8_MMA(1, 0, At, B0); PG8_MMA(1, 1, At, B1); PG8_BAR; PG8_SCHED;
            } else {
            PG8_LDB(B0, 0, 0); PG8_SCHED; PG8_LDA(At, 0, 0); PG8_STAGE(PG8_SA(1, 1), a1 + hstep, voffA);
            PG8_WAIT_L(8); PG8_BAR; PG8_WAIT_L(0); PG8_MMA(0, 0, At, B0); PG8_BAR; PG8_SCHED;
            PG8_LDB(B1, 0, 1); PG8_STAGE(PG8_SB(0, 0), b2, voffB);
            PG8_BAR; PG8_WAIT_L(0); PG8_MMA(0, 1, At, B1); PG8_BAR;
            PG8_LDA(At, 0, 1); PG8_STAGE(PG8_SA(0, 0), a2, voffA);
            PG8_BAR; PG8_WAIT_L(0); PG8_MMA(1, 0, At, B0); PG8_BAR; PG8_SCHED;
            PG8_STAGE(PG8_SB(0, 1), b2 + hstep, voffB);
            PG8_WAIT_V(6); PG8_BAR; PG8_MMA(1, 1, At, B1); PG8_BAR;
            PG8_LDB(B0, 1, 0); PG8_SCHED; PG8_LDA(At, 1, 0); PG8_STAGE(PG8_SA(0, 1), a2 + hstep, voffA);
            PG8_WAIT_L(8); PG8_BAR; PG8_WAIT_L(0); PG8_MMA(0, 0, At, B0); PG8_BAR; PG8_SCHED;
            PG8_LDB(B1, 1, 1); PG8_STAGE(PG8_SB(1, 0), b3, voffB);
            PG8_BAR; PG8_WAIT_L(0); PG8_MMA(0, 1, At, B1); PG8_BAR;
            PG8_LDA(At, 1, 1); PG8_STAGE(PG8_SA(1, 0), a3, voffA);
            PG8_BAR; PG8_WAIT_L(0); PG8_MMA(1, 0, At, B0); PG8_BAR; PG8_SCHED;
            PG8_STAGE(PG8_SB(1, 1), b3 + hstep, voffB);
            PG8_WAIT_V(6); PG8_BAR; PG8_MMA(1, 1, At, B1); PG8_BAR;
            }
        }
        if constexpr (ALIGN_EPI) { if (wr == 0) PG8_BAR; }
        if constexpr (!Epi::AFTER_DRAIN) { if constexpr (Epi::NEEDS_LDS) E.run(acc, cur, wr, wc, lds + 132096); else E(acc, cur, wr, wc, fr, fq); S.done(cur); }
        if (!has_next) break;
#pragma unroll
        for (int a = 0; a < 2; ++a)
#pragma unroll
            for (int b = 0; b < 2; ++b)
#pragma unroll
                for (int m = 0; m < 4; ++m)
#pragma unroll
                    for (int n = 0; n < 2; ++n) acc[a][b][m][n] = (f32x4){0.f, 0.f, 0.f, 0.f};
        cur = nxt; cA = nA; cB = nB; ++ui;
        if constexpr (ALIGN_EPI) { if (wr == 1) PG8_BAR; }
    }
    PG8_WAIT_V(0);
    if constexpr (!ALIGN_EPI) { if (wr == 0) PG8_BAR; }
    PG8_BAR;
#undef PG8_SA
#undef PG8_SB
#undef PG8_STAGE
#undef PG8_LDA
#undef PG8_LDB
#undef PG8_MMA
#undef PG8_WAIT_V
#undef PG8_WAIT_L
#undef PG8_BAR
#undef PG8_SCHED
}
}

constexpr int NWAVES = 8, NTHR = 512;
constexpr int DM = 1024, M = 49152, NTP = 16384, SP = 2048, SS = 16384;
constexpr int NIN = 2560, DFF = 2816, NUP = 5632, NH = 12, HD = 64, PW = 256;
constexpr float EPS = 1e-6f;

constexpr size_t MiB = 1u << 20;
constexpr size_t WS_CTL = 0, CTL_ZERO_BYTES = 65536;
constexpr size_t WS_ROPE = 1 * MiB;
constexpr size_t WS_WIN = 2 * MiB, WS_WOUT = 8 * MiB, WS_WUP = 10 * MiB, WS_WDN = 21 * MiB;
constexpr size_t WS_SSQ = 27 * MiB;
constexpr size_t WS_RS1 = 30 * MiB, WS_RS2 = 31 * MiB;
constexpr size_t WS_H = 32 * MiB;
constexpr size_t WS_P = 128 * MiB, WS_Q = 152 * MiB, WS_K = 224 * MiB, WS_V = 296 * MiB, WS_Y = 128 * MiB;
constexpr size_t WS_X1 = 392 * MiB;
constexpr size_t WS_ACT = 128 * MiB, WS_Z = 32 * MiB, WS_END = 489 * MiB;
constexpr int CW_BAR = 4096;

constexpr int RING_BYTES = 131072, LDSCTL_OFF = RING_BYTES, MISC_OFF = LDSCTL_OFF + 320, LDS_BYTES = 147456;

#define GAS __attribute__((address_space(1)))
#define LAS __attribute__((address_space(3)))
typedef unsigned short bf16;
typedef unsigned v4u __attribute__((ext_vector_type(4)));
typedef unsigned v2u __attribute__((ext_vector_type(2)));
typedef float f32x4 __attribute__((ext_vector_type(4)));
#define LDS_WAIT() asm volatile("s_waitcnt lgkmcnt(0)" ::: "memory")

__device__ __forceinline__ unsigned f2bf(float f) { unsigned u = __builtin_bit_cast(unsigned, f); return (u + 0x7fffu + ((u >> 16) & 1u)) >> 16; }
__device__ __forceinline__ unsigned pk2(float lo, float hi) { return f2bf(lo) | (f2bf(hi) << 16); }
__device__ __forceinline__ float bflo(unsigned w) { return __builtin_bit_cast(float, w << 16); }
__device__ __forceinline__ float bfhi(unsigned w) { return __builtin_bit_cast(float, w & 0xffff0000u); }

#define XB_TMO      128
#define XB_XCNT(j)  (256  + 64 * (j))
#define XB_XSUB(j)  (1280 + 64 * (j))
#define XB_XGEN(j)  (2304 + 64 * (j))
#define XB_TOP      3328
#define XB_TOPGEN   3392
#define XCD_BAR_WORDS 3456
#define XB_SPIN_CAP (1u << 18)
__device__ __forceinline__ unsigned xb_ld(unsigned* p)              { return __hip_atomic_load(p, __ATOMIC_RELAXED, __HIP_MEMORY_SCOPE_AGENT); }
__device__ __forceinline__ unsigned xb_add(unsigned* p, unsigned v) { return __hip_atomic_fetch_add(p, v, __ATOMIC_RELAXED, __HIP_MEMORY_SCOPE_AGENT); }
__device__ __forceinline__ unsigned xb_xcc_id() { return (unsigned)__builtin_amdgcn_s_getreg((3 << 11) | 20) & 0xFu; }
#define XB_SPIN(cond, bar) do { unsigned _sp = 0; while (cond) { __builtin_amdgcn_s_sleep(1); \
    if ((++_sp & 255u) == 0u) { if (xb_ld(&(bar)[XB_TMO])) break; if (_sp > XB_SPIN_CAP) { atomicAdd(&(bar)[XB_TMO], 1u); break; } } } } while (0)
struct XcdBarrier { unsigned* bar; unsigned x; volatile LAS unsigned* st; };
__device__ __forceinline__ XcdBarrier xcd_barrier_post(unsigned* bar, volatile LAS unsigned* st) {
    XcdBarrier b; b.bar = bar; b.x = xb_xcc_id(); b.st = st;
    if (threadIdx.x == 0) (void)xb_add(&bar[XB_XCNT(b.x)], 1u);
    return b;
}
__device__ __forceinline__ void xcd_barrier_complete(unsigned* bar, unsigned x, unsigned& nloc, unsigned& nx) {
    const unsigned G = gridDim.x * gridDim.y * gridDim.z;
    unsigned sum, cnt, mine, sp = 0u;
    for (;;) {
        sum = 0u; cnt = 0u; mine = 0u;
#pragma unroll
        for (unsigned j = 0; j < 16; ++j) { const unsigned c = xb_ld(&bar[XB_XCNT(j)]); sum += c; cnt += (c > 0u) ? 1u : 0u; mine = (j == x) ? c : mine; }
        if (sum == G) break;
        __builtin_amdgcn_s_sleep(1);
        if ((++sp & 255u) == 0u) { if (xb_ld(&bar[XB_TMO])) break; if (sp > XB_SPIN_CAP) { atomicAdd(&bar[XB_TMO], 1u); break; } }
    }
    nloc = mine > 0u ? mine : 1u; nx = cnt > 0u ? cnt : 1u;
}
__device__ __forceinline__ void xcd_barrier(const XcdBarrier& b) {
    asm volatile("s_waitcnt vmcnt(0)" ::: "memory");
    __syncthreads();
    if (threadIdx.x == 0) {
        unsigned* bar = b.bar;
        __builtin_amdgcn_s_waitcnt(0);
        unsigned nloc = b.st[0], nx = b.st[1];
        if (nloc == 0u) { xcd_barrier_complete(bar, b.x, nloc, nx); b.st[0] = nloc; b.st[1] = nx; }
        const unsigned old = xb_add(&bar[XB_XSUB(b.x)], 1u);
        const unsigned gen = old / nloc;
        if (old + 1u == (gen + 1u) * nloc) {
            __builtin_amdgcn_fence(__ATOMIC_RELEASE, "agent");
            asm volatile("s_waitcnt vmcnt(0)" ::: "memory");
            const unsigned og = xb_add(&bar[XB_TOP], 1u);
            const unsigned tg = og / nx;
            if (og + 1u == (tg + 1u) * nx) xb_add(&bar[XB_TOPGEN], 1u);
            else XB_SPIN(xb_ld(&bar[XB_TOPGEN]) == tg, bar);
            __builtin_amdgcn_fence(__ATOMIC_ACQUIRE, "agent");
            xb_add(&bar[XB_XGEN(b.x)], 1u);
            asm volatile("s_waitcnt vmcnt(0)" ::: "memory");
        } else {
            XB_SPIN(xb_ld(&bar[XB_XGEN(b.x)]) == gen, bar);
            __builtin_amdgcn_fence(__ATOMIC_ACQUIRE, "agent");
            asm volatile("s_waitcnt vmcnt(0)" ::: "memory");
        }
    }
    __syncthreads();
}

__device__ __forceinline__ float wave_sum(float v) {
#pragma unroll
    for (int o = 1; o < 64; o <<= 1) v += __shfl_xor(v, o);
    return v;
}
__device__ __forceinline__ const float* xrow_ptr(const float* xp, const float* xs, int m) { return m < NTP ? xp + (size_t)m * DM : xs + (size_t)(m - NTP) * DM; }
__device__ __forceinline__ void seq_of(int m, int& s0, int& S) { if (m < NTP) { s0 = m & ~(SP - 1); S = SP; } else { s0 = NTP + ((m - NTP) & ~(SS - 1)); S = SS; } }

__device__ __forceinline__ void p0_transpose_item(const float* W, int K, int N, bf16* WT, LAS float* scr, int item, int lane, const float* ga = nullptr, const float* gb = nullptr, int gsplit = 0, bool upmap = false) {
    const int nblk = N / 32, kb = item / nblk, nb = item % nblk, k0 = 64 * kb, n0 = 32 * nb;
    int nd0 = n0; if (upmap) { const int bj = n0 >= DFF ? 1 : 0, ch = n0 - DFF * bj; nd0 = 256 * (ch >> 7) + 128 * bj + (ch & 127); }
#pragma unroll 8
    for (int i = 0; i < 32; ++i) { const int kk = 2 * i + (lane >> 5); float wv = __builtin_nontemporal_load(W + (size_t)(k0 + kk) * N + n0 + (lane & 31));
        if (ga) { const int k = k0 + kk; wv *= (k < gsplit ? ga[k] : gb[k - gsplit]); }
        scr[kk * 33 + (lane & 31)] = wv; }
    LDS_WAIT(); asm volatile("" ::: "memory");
    const int c = lane & 7;
#pragma unroll
    for (int j = 0; j < 4; ++j) { const int n = (lane >> 3) + 8 * j; const LAS float* s = scr + (8 * c) * 33 + n;
        v4u o; o.x = pk2(s[0 * 33], s[1 * 33]); o.y = pk2(s[2 * 33], s[3 * 33]); o.z = pk2(s[4 * 33], s[5 * 33]); o.w = pk2(s[6 * 33], s[7 * 33]);
        *(v4u*)(WT + (size_t)(nd0 + n) * K + k0 + 8 * c) = o; }
    LDS_WAIT(); asm volatile("" ::: "memory");
}

__constant__ double ROPE_REV[8] = {0.15915494309189535, 0.03086376340470123, 0.005985185712713705, 0.001160663641240061,
                                   0.00022507907903927653, 4.364795279280289e-05, 8.464330808241401e-06, 1.6414262627950345e-06};

__device__ __forceinline__ float rows_max(float v) {
    auto a = __builtin_amdgcn_permlane16_swap(__float_as_uint(v), __float_as_uint(v), false, false); v = fmaxf(__uint_as_float(a[0]), __uint_as_float(a[1]));
    auto b = __builtin_amdgcn_permlane32_swap(__float_as_uint(v), __float_as_uint(v), false, false); return fmaxf(__uint_as_float(b[0]), __uint_as_float(b[1]));
}
__device__ __forceinline__ float rows_sum(float v) {
    auto a = __builtin_amdgcn_permlane16_swap(__float_as_uint(v), __float_as_uint(v), false, false); v = __uint_as_float(a[0]) + __uint_as_float(a[1]);
    auto b = __builtin_amdgcn_permlane32_swap(__float_as_uint(v), __float_as_uint(v), false, false); return __uint_as_float(b[0]) + __uint_as_float(b[1]);
}
struct Args { const float* in[16]; float* out; unsigned char* ws; };

__global__ void __launch_bounds__(NTHR, 2) hymba_fwd(Args args) {
    extern __shared__ __attribute__((aligned(16))) unsigned char lds[];
    cg::grid_group grid = cg::this_grid();
    LAS unsigned char* L = (LAS unsigned char*)lds;
    const int tid = threadIdx.x, lane = tid & 63, wave = __builtin_amdgcn_readfirstlane(tid >> 6);
    const int G = gridDim.x, bx = blockIdx.x;
    const int vcu = (G % 8 == 0) ? (bx % 8) * (G / 8) + bx / 8 : bx;
    const int gw = vcu * NWAVES + wave, NGW = G * NWAVES;
#define xp (args.in[0])
#define xs (args.in[1])
#define g_mix_pre (args.in[2])
#define g_mix_post (args.in[3])
#define w_in (args.in[4])
#define pool_w (args.in[5])
#define pool_scale (args.in[6])
#define g_pool_out (args.in[7])
#define g_attn_out (args.in[8])
#define w_out (args.in[9])
#define g_ffn_pre (args.in[10])
#define g_ffn_post (args.in[11])
#define w_up (args.in[12])
#define conv_w (args.in[13])
#define conv_b (args.in[14])
#define w_down (args.in[15])
#define out (args.out)
#define ws (args.ws)
#define Wt_in ((bf16*)(ws + WS_WIN))
#define Wt_out ((bf16*)(ws + WS_WOUT))
#define Wt_up ((bf16*)(ws + WS_WUP))
#define Wt_dn ((bf16*)(ws + WS_WDN))
#define rope ((float*)(ws + WS_ROPE))
#define Hb ((bf16*)(ws + WS_H))
#define Pb ((bf16*)(ws + WS_P))
#define Qb ((bf16*)(ws + WS_Q))
#define Kb ((bf16*)(ws + WS_K))
#define Vb ((bf16*)(ws + WS_V))
#define Yb ((bf16*)(ws + WS_Y))
#define ACTb ((bf16*)(ws + WS_ACT))
#define Zb ((bf16*)(ws + WS_Z))
#define SSQ ((float*)(ws + WS_SSQ))
#define RS1 ((float*)(ws + WS_RS1))
#define RS2 ((float*)(ws + WS_RS2))
#define MIXb ((bf16*)(ws + WS_X1))
#define X1b ((bf16*)(ws + WS_X1))

    for (int u = tid; u < (LDS_BYTES - LDSCTL_OFF) / 4; u += NTHR) ((LAS unsigned*)(L + LDSCTL_OFF))[u] = 0u;
    __syncthreads();
#if !USE_CG_SYNC
    XcdBarrier bar = xcd_barrier_post((unsigned*)(ws + WS_CTL) + CW_BAR, (volatile LAS unsigned*)(L + MISC_OFF) + 8);
#define GRID_BAR() xcd_barrier(bar)
#else
#define GRID_BAR() grid.sync()
#endif
#define GRID_BAR_CG() grid.sync()

#ifndef SKIP_P0
    {
        int tid0 = threadIdx.x; asm volatile("" : "+v"(tid0)); const int tid = tid0, lane = tid0 & 63;
        LAS float* scr = (LAS float*)(L + wave * 16384);
        constexpr int I_IN = (DM / 64) * (NIN / 32), I_OUT = (DM / 64) * (DM / 32), I_UP = (DM / 64) * (NUP / 32), I_DN = (DFF / 64) * (DM / 32);
        constexpr int NITEMS = I_IN + I_OUT + I_UP + I_DN;
        for (int it = gw; it < NITEMS; it += NGW) {
            int r = it;
            if (r < I_IN) { p0_transpose_item(w_in, DM, NIN, Wt_in, scr, r, lane, g_mix_pre, g_mix_pre, DM); continue; } r -= I_IN;
            if (r < I_OUT) { p0_transpose_item(w_out, DM, DM, Wt_out, scr, r, lane, g_pool_out, g_attn_out, PW); continue; } r -= I_OUT;
            if (r < I_UP) { p0_transpose_item(w_up, DM, NUP, Wt_up, scr, r, lane, g_ffn_pre, g_ffn_pre, DM, true); continue; } r -= I_UP;
            p0_transpose_item(w_down, DFF, DM, Wt_dn, scr, r, lane);
        }
        for (int idx = bx * NTHR + tid; idx < SS * 8; idx += G * NTHR) {
            const int t = idx >> 3, i = idx & 7;
            double x = (double)t * ROPE_REV[i]; x -= __builtin_rint(x);
            const float xf = (float)x;
            rope[t * 16 + i] = __builtin_amdgcn_cosf(xf); rope[t * 16 + 8 + i] = __builtin_amdgcn_sinf(xf);
        }
        for (int mb = gw; mb < M; mb += 4 * NGW) {
            f32x4 v[4][4];
#pragma unroll
            for (int k = 0; k < 4; ++k) { const f32x4* xr = (const f32x4*)xrow_ptr(xp, xs, mb + k * NGW) + lane;
#pragma unroll
                for (int j = 0; j < 4; ++j) v[k][j] = __builtin_nontemporal_load(xr + 64 * j); }
#pragma unroll
            for (int k = 0; k < 4; ++k) { const int m = mb + k * NGW; float sq = 0.f;
#pragma unroll
                for (int j = 0; j < 4; ++j) sq += (v[k][j].x * v[k][j].x + v[k][j].y * v[k][j].y) + (v[k][j].z * v[k][j].z + v[k][j].w * v[k][j].w);
                const float r = 1.f / sqrtf(wave_sum(sq) * (1.f / DM) + EPS);
                if (lane == 0) RS1[m] = r;
                unsigned long long* o8 = (unsigned long long*)(Hb + (size_t)m * DM) + lane;
#pragma unroll
                for (int j = 0; j < 4; ++j) o8[64 * j] = (unsigned long long)pk2(v[k][j].x, v[k][j].y) | ((unsigned long long)pk2(v[k][j].z, v[k][j].w) << 32); }
        }
    }
#endif
    GRID_BAR();
    if (gridDim.x > 65535u) GRID_BAR_CG();

#ifndef SKIP_P1
    {
        pg8::Gemm g{Hb, Wt_in, M, NIN, DM}; pg8::StaticOrder S; S.init(M, NIN, G, bx);
        pg8::EpiProj E{Pb, Qb, rope, RS1};
        pg8::gemm_phase<pg8::EpiProj, pg8::StaticOrder, true, true>(L, g, S, E);
    }
#endif
    GRID_BAR();

#ifndef SKIP_P2A
    {
        int tida = threadIdx.x; asm volatile("" : "+v"(tida));
        const int lane_a = tida & 63, fr = lane_a & 15, fq = lane_a >> 4, vrow = lane_a >> 3, vch = lane_a & 7;
        LAS unsigned char* OACC = L;
        LAS float* MLA = (LAS float*)(L + 65536);
        LAS unsigned char* VST = L + 67584 + wave * 6144;
        constexpr int NUNIT = NH * (M / 256);
        const int nu = vcu < NUNIT ? (NUNIT - vcu + G - 1) / G : 0, nj = nu * 6;
        typedef short s16x4 __attribute__((ext_vector_type(4)));
        typedef short v4i16_t __attribute__((ext_vector_type(4)));
#define ATT_PARAMS(J, h_, m0_, S_, B_, Bo_, d_, p_, off_) do { const int ui_ = (J) / 6, jb_ = (J) - 6 * ui_; const int unit_ = ui_ * G + vcu; h_ = unit_ / (M / 256); m0_ = (unit_ % (M / 256)) * 256; \
            int s0_; seq_of(m0_, s0_, S_); p_ = jb_ >> 1; const int tau_ = wave + 8 * (jb_ & 1); d_ = p_ == 0 ? 1 : (p_ == 1 ? 4 : 16); \
            Bo_ = p_ == 0 ? 16 * tau_ : (p_ == 1 ? 64 * (tau_ >> 2) + (tau_ & 3) : tau_); B_ = (m0_ - s0_) + Bo_; off_ = ((size_t)h_ * M + s0_) * 64; } while (0)
#define ATT_QLOAD(B_, d_, S_, off_) do { const char* Qh_ = (const char*)(Qb + (off_)); const unsigned tq_ = (unsigned)((B_) + (d_) * fr); \
            qf[0] = *(const pg8::bf16x8*)(Qh_ + (tq_ * 128u + 16u * fq)); qf[1] = *(const pg8::bf16x8*)(Qh_ + (tq_ * 128u + 16u * fq) + 64); } while (0)
  \
#define ATT_KLOAD(third, B_, d_, S_, off_) do { const char* Kh_ = (const char*)(Kb + (off_)); const int tv0_ = (B_) + (d_) * (48 * (third) + vrow - 64), sv_ = 8 * (d_); \
            _Pragma("unroll") for (int j = 0; j < 6; ++j) { const unsigned tk = (unsigned)min(max(tv0_ + j * sv_, 0), (S_) - 1); \
            kreg[6 * (third) + j] = *(const v4u*)(Kh_ + (tk * 128u + 16u * (unsigned)(vch ^ ((4 * j + (vrow >> 1)) & 7)))); } } while (0)
#define ATT_VLOAD(third, B_, d_, S_, off_) do { const char* Vh_ = (const char*)(Vb + (off_)); const int tv0_ = (B_) + (d_) * (48 * (third) + vrow - 64), sv_ = 8 * (d_); \
            _Pragma("unroll") for (int j = 0; j < 6; ++j) { const unsigned tk = (unsigned)min(max(tv0_ + j * sv_, 0), (S_) - 1); \
            vreg[6 * (third) + j] = *(const v4u*)(Vh_ + (tk * 128u + vsw)); } } while (0)
        const unsigned vsw = 16u * (unsigned)(vch ^ (((vrow >> 1) & 3) << 1));
        pg8::bf16x8 qf[2]; v4u kreg[18], vreg[18];
        int h = 0, m0 = 0, S = 1, B = 0, Bo = 0, d = 1, p = 0; size_t off = 0;
        if (nj > 0) { ATT_PARAMS(0, h, m0, S, B, Bo, d, p, off); ATT_QLOAD(B, d, S, off); ATT_KLOAD(0, B, d, S, off); ATT_KLOAD(1, B, d, S, off); ATT_KLOAD(2, B, d, S, off); ATT_VLOAD(0, B, d, S, off); ATT_VLOAD(1, B, d, S, off); ATT_VLOAD(2, B, d, S, off); }
#pragma unroll 1
        for (int J = 0; J < nj; ++J) {
            int hn, m0n, Sn, Bn, Bon, dn, pn; size_t offn; { const int Jn = J + 1 < nj ? J + 1 : J; ATT_PARAMS(Jn, hn, m0n, Sn, Bn, Bon, dn, pn, offn); }
            f32x4 sc[9];
#pragma unroll
            for (int third = 0; third < 3; ++third) {
                { const char* Kh_ = (const char*)(Kb + offn); const int tv0_ = Bn + dn * (48 * third + vrow - 64), sv_ = 8 * dn;
#pragma unroll
                  for (int j = 0; j < 6; ++j) { *(LAS v4u*)(VST + (8 * j + vrow) * 128 + 16 * vch) = kreg[6 * third + j];
                      const unsigned tk = (unsigned)min(max(tv0_ + j * sv_, 0), Sn - 1);
                      kreg[6 * third + j] = *(const v4u*)(Kh_ + (tk * 128u + 16u * (unsigned)(vch ^ ((4 * j + (vrow >> 1)) & 7)))); } }
#pragma unroll
                for (int pc = 0; pc < 3; ++pc) { const int R = 16 * pc + fr, ks_ = (R >> 1) & 7;
                    const pg8::bf16x8 k0 = *(const LAS pg8::bf16x8*)(VST + R * 128 + 16 * (fq ^ ks_)), k1 = *(const LAS pg8::bf16x8*)(VST + R * 128 + 16 * ((fq + 4) ^ ks_));
                    f32x4 c = (f32x4){0.f, 0.f, 0.f, 0.f};
                    c = __builtin_amdgcn_mfma_f32_16x16x32_bf16(k0, qf[0], c, 0, 0, 0);
                    c = __builtin_amdgcn_mfma_f32_16x16x32_bf16(k1, qf[1], c, 0, 0, 0); sc[3 * third + pc] = c; }
            }
            ATT_QLOAD(Bn, dn, Sn, offn);
#define ATT_VIMAGE(third) do { const char* Vh_ = (const char*)(Vb + offn); const int tv0_ = Bn + dn * (48 * (third) + vrow - 64), sv_ = 8 * dn; \
                  _Pragma("unroll") for (int j = 0; j < 6; ++j) { *(LAS v4u*)(VST + (8 * j + vrow) * 128 + 16 * vch) = vreg[6 * (third) + j]; \
                      const unsigned tk = (unsigned)min(max(tv0_ + j * sv_, 0), Sn - 1); \
                      vreg[6 * (third) + j] = *(const v4u*)(Vh_ + (tk * 128u + vsw)); } } while (0)
            ATT_VIMAGE(0);
#pragma unroll
            for (int r = 0; r < 4; ++r) { if (4 * fq + r < fr) sc[0][r] = -INFINITY; if (4 * fq + r > fr) sc[8][r] = -INFINITY; }
            if (B - 64 * d < 0 || B + 79 * d >= S) {
                const int klo = 64 - (B >> (2 * p)), khi = 64 + ((S - 1 - B) >> (2 * p));
                const int lo_l = klo - 4 * fq, hi_l = khi - 4 * fq;
#pragma unroll
                for (int kb = 0; kb < 9; ++kb)
#pragma unroll
                    for (int r = 0; r < 4; ++r) { if (16 * kb + r < lo_l || 16 * kb + r > hi_l) sc[kb][r] = -INFINITY; }
            }
            float mx = __builtin_fmaxf(__builtin_fmaxf(sc[0][0], sc[0][1]), __builtin_fmaxf(sc[0][2], sc[0][3]));
#pragma unroll
            for (int kb = 1; kb < 9; ++kb) { mx = __builtin_fmaxf(__builtin_fmaxf(mx, sc[kb][0]), sc[kb][1]); mx = __builtin_fmaxf(__builtin_fmaxf(mx, sc[kb][2]), sc[kb][3]); }
            mx = rows_max(mx);
            float ls = 0.f;
            s16x4 pf[9];
#pragma unroll
            for (int kb = 0; kb < 9; ++kb) { f32x4 e;
#pragma unroll
                for (int r = 0; r < 4; ++r) { e[r] = __builtin_amdgcn_exp2f(sc[kb][r] - mx); ls += e[r]; }
                v2u w; w.x = pg8::cvt_pk_bf16(e[0], e[1]); w.y = pg8::cvt_pk_bf16(e[2], e[3]); pf[kb] = __builtin_bit_cast(s16x4, w); }
            ls = rows_sum(ls);
            f32x4 o[4];
#pragma unroll
            for (int nb = 0; nb < 4; ++nb) o[nb] = (f32x4){0.f, 0.f, 0.f, 0.f};
#pragma unroll
            for (int third = 0; third < 3; ++third) {
                if (third > 0) ATT_VIMAGE(third);
#pragma unroll
                for (int pc = 0; pc < 3; ++pc) {
                    const int R = 16 * pc + 4 * fq + (fr >> 2), pp = fr & 3;
#pragma unroll
                    for (int nb = 0; nb < 4; ++nb) {
                        const s16x4 vt = __builtin_bit_cast(s16x4, __builtin_amdgcn_ds_read_tr16_b64_v4i16((LAS v4i16_t*)(VST + R * 128 + 16 * ((2 * nb + (pp >> 1)) ^ (((R >> 1) & 3) << 1)) + 8 * (pp & 1))));
                        o[nb] = __builtin_amdgcn_mfma_f32_16x16x16bf16_1k(vt, pf[3 * third + pc], o[nb], 0, 0, 0);
                    }
                }
            }
            const int u = Bo + d * fr, sw = (u ^ (u >> 4)) & 15;
            if (p > 0) {
                const float ma = MLA[2 * u], la = MLA[2 * u + 1];
                const float mn = fmaxf(ma, mx), fa = __builtin_amdgcn_exp2f(ma - mn), fb = __builtin_amdgcn_exp2f(mx - mn);
                ls = la * fa + ls * fb; mx = mn;
#pragma unroll
                for (int nb = 0; nb < 4; ++nb) { const f32x4 oa = *(LAS f32x4*)(OACC + u * 256 + 16 * ((4 * nb + fq) ^ sw)); o[nb] = oa * fa + o[nb] * fb; }
            }
            if (p < 2) {
                if (fq == 0) { MLA[2 * u] = mx; MLA[2 * u + 1] = ls; }
#pragma unroll
                for (int nb = 0; nb < 4; ++nb) *(LAS f32x4*)(OACC + u * 256 + 16 * ((4 * nb + fq) ^ sw)) = o[nb];
            } else {
                const float inv = 1.f / ls;
                bf16* op = MIXb + (size_t)(m0 + u) * DM + PW + h * 64 + 4 * fq;
                float sq = 0.f;
#pragma unroll
                for (int nb = 0; nb < 4; ++nb) { const f32x4 ov = o[nb] * inv; sq += (ov[0] * ov[0] + ov[1] * ov[1]) + (ov[2] * ov[2] + ov[3] * ov[3]);
                    v2u w; w.x = pg8::cvt_pk_bf16(ov[0], ov[1]); w.y = pg8::cvt_pk_bf16(ov[2], ov[3]); *(v2u*)(op + 16 * nb) = w; }
                sq = rows_sum(sq);
                if (fq == 0) SSQ[(size_t)(m0 + u) * NH + h] = sq;
            }
            if ((J & 1) == 1) __syncthreads();
            h = hn; m0 = m0n; S = Sn; B = Bn; Bo = Bon; d = dn; p = pn; off = offn;
        }
#undef ATT_PARAMS
#undef ATT_VIMAGE
#undef ATT_QLOAD
#undef ATT_KLOAD
#undef ATT_VLOAD
    }
#endif
#ifndef SKIP_P2B
    {
        int tidp = threadIdx.x; asm volatile("" : "+v"(tidp));
        const int lp = tidp & 63, fr = lp & 15, fq = lp >> 4;
        constexpr int PPITCH = 528;
        LAS unsigned char* PST = L;
        LAS unsigned char* POOL = L + 80 * PPITCH;
        LAS float* SSP = (LAS float*)(L + 144 * PPITCH);
        const int g = wave & 3, th = wave >> 2;
        pg8::bf16x8 wf[4][2];
#pragma unroll
        for (int eb = 0; eb < 4; ++eb)
#pragma unroll
            for (int ks = 0; ks < 2; ++ks) { const float* wp = pool_w + ((size_t)(g * 64 + 32 * ks + 8 * fq) * 64 + 16 * eb + fr);
                v4u w; w.x = pk2(wp[0], wp[64]); w.y = pk2(wp[128], wp[192]); w.z = pk2(wp[256], wp[320]); w.w = pk2(wp[384], wp[448]); wf[eb][ks] = __builtin_bit_cast(pg8::bf16x8, w); }
        for (int item = bx; item < M / 64; item += G) {
            const int m0 = item * 64;
            int s0, S; seq_of(m0, s0, S);
            const int t0 = m0 - s0;
            for (int q = tidp; q < 80 * 32; q += NTHR) { const int row = q >> 5, ch = q & 31; const int t = t0 - 8 + row;
                if (t >= 0 && t < S) *(LAS v4u*)(PST + row * PPITCH + 16 * ch) = *(const v4u*)(Pb + (size_t)(s0 + t) * PW + 8 * ch); }
            __syncthreads();
            { const int tok = tidp >> 3, part = tidp & 7, gg = part >> 1, hw = 1 << gg; const int t = t0 + tok;
              const int lo = (t - hw) > 0 ? (t - hw) : 0, hi = (t + hw) < S ? (t + hw) : S;
              float sum[32];
#pragma unroll
              for (int i = 0; i < 32; ++i) sum[i] = 0.f;
              for (int tr = lo; tr < hi; ++tr) { const LAS v4u* rp = (const LAS v4u*)(PST + (tr - t0 + 8) * PPITCH + 64 * part);
#pragma unroll
                  for (int c = 0; c < 4; ++c) { const v4u w = rp[c]; sum[8 * c + 0] += bflo(w.x); sum[8 * c + 1] += bfhi(w.x); sum[8 * c + 2] += bflo(w.y); sum[8 * c + 3] += bfhi(w.y);
                      sum[8 * c + 4] += bflo(w.z); sum[8 * c + 5] += bfhi(w.z); sum[8 * c + 6] += bflo(w.w); sum[8 * c + 7] += bfhi(w.w); } }
              const float rc = 1.f / (float)(hi - lo);
              const LAS v4u* cp = (const LAS v4u*)(PST + (tok + 8) * PPITCH + 64 * part);
#pragma unroll
              for (int c = 0; c < 4; ++c) { const v4u w = cp[c]; v4u o;
                  o.x = pk2(sum[8 * c + 0] * rc - bflo(w.x), sum[8 * c + 1] * rc - bfhi(w.x)); o.y = pk2(sum[8 * c + 2] * rc - bflo(w.y), sum[8 * c + 3] * rc - bfhi(w.y));
                  o.z = pk2(sum[8 * c + 4] * rc - bflo(w.z), sum[8 * c + 5] * rc - bfhi(w.z)); o.w = pk2(sum[8 * c + 6] * rc - bflo(w.w), sum[8 * c + 7] * rc - bfhi(w.w));
                  *(LAS v4u*)(POOL + tok * PPITCH + 64 * part + 16 * c) = o; } }
            __syncthreads();
            f32x4 acc[2][4];
#pragma unroll
            for (int tb = 0; tb < 2; ++tb) {
                const LAS unsigned char* prow = POOL + (32 * th + 16 * tb + fr) * PPITCH + 128 * g + 16 * fq;
                const pg8::bf16x8 b0 = *(const LAS pg8::bf16x8*)(prow), b1 = *(const LAS pg8::bf16x8*)(prow + 64);
#pragma unroll
                for (int eb = 0; eb < 4; ++eb) { f32x4 c = (f32x4){0.f, 0.f, 0.f, 0.f};
                    c = __builtin_amdgcn_mfma_f32_16x16x32_bf16(wf[eb][0], b0, c, 0, 0, 0); c = __builtin_amdgcn_mfma_f32_16x16x32_bf16(wf[eb][1], b1, c, 0, 0, 0);
                    const f32x4 sv = *(const f32x4*)(pool_scale + g * 64 + 16 * eb + 4 * fq); acc[tb][eb] = c * sv; }
                float sq = 0.f;
#pragma unroll
                for (int eb = 0; eb < 4; ++eb) sq += (acc[tb][eb][0] * acc[tb][eb][0] + acc[tb][eb][1] * acc[tb][eb][1]) + (acc[tb][eb][2] * acc[tb][eb][2] + acc[tb][eb][3] * acc[tb][eb][3]);
                sq += __shfl_xor(sq, 16); sq += __shfl_xor(sq, 32);
                if (fq == 0) SSP[(32 * th + 16 * tb + fr) * 4 + g] = sq;
            }
            __syncthreads();
#pragma unroll
            for (int tb = 0; tb < 2; ++tb) { const int tok = 32 * th + 16 * tb + fr; const f32x4 pp = *(const LAS f32x4*)(SSP + tok * 4);
                const float r = 1.f / sqrtf(((pp[0] + pp[1]) + (pp[2] + pp[3])) * (1.f / PW) + EPS);
                bf16* op = MIXb + (size_t)(m0 + tok) * DM + g * 64 + 4 * fq;
#pragma unroll
                for (int eb = 0; eb < 4; ++eb) { const f32x4 v = acc[tb][eb] * r; v2u w; w.x = pg8::cvt_pk_bf16(v[0], v[1]); w.y = pg8::cvt_pk_bf16(v[2], v[3]); *(v2u*)(op + 16 * eb) = w; } }
        }
        __syncthreads();
    }
#endif
    GRID_BAR();

#ifndef SKIP_P3
    {
        pg8::Gemm g{MIXb, Wt_out, M, DM, DM}; pg8::StaticOrder S; S.init(M, DM, G, bx);
        pg8::EpiOutProj E{Yb, DM, SSQ};
        pg8::gemm_phase<pg8::EpiOutProj, pg8::StaticOrder, true, true>(L, g, S, E);
    }
#endif
    GRID_BAR();

#ifndef SKIP_P4
    { int tid4 = threadIdx.x; asm volatile("" : "+v"(tid4)); const int lane = tid4 & 63;
    for (int mb = gw; mb < M; mb += 4 * NGW) {
        f32x4 y[4][4], x[4][4];
#pragma unroll
        for (int k = 0; k < 4; ++k) { const int m = mb + k * NGW; const v2u* xr = (const v2u*)(Hb + (size_t)m * DM) + lane; const v2u* yr = (const v2u*)(Yb + (size_t)m * DM) + lane;
#pragma unroll
            for (int j = 0; j < 4; ++j) { const v2u w = __builtin_nontemporal_load(yr + 64 * j); y[k][j] = (f32x4){bflo(w.x), bfhi(w.x), bflo(w.y), bfhi(w.y)}; const v2u xw = __builtin_nontemporal_load(xr + 64 * j); x[k][j] = (f32x4){bflo(xw.x), bfhi(xw.x), bflo(xw.y), bfhi(xw.y)}; } }
#pragma unroll
        for (int k = 0; k < 4; ++k) { const int m = mb + k * NGW; float s = 0.f;
#pragma unroll
            for (int j = 0; j < 4; ++j) s += (y[k][j].x * y[k][j].x + y[k][j].y * y[k][j].y) + (y[k][j].z * y[k][j].z + y[k][j].w * y[k][j].w);
            const float r = 1.f / sqrtf(wave_sum(s) * (1.f / DM) + EPS);
            float s2 = 0.f;
            unsigned long long* x1row = (unsigned long long*)(X1b + (size_t)m * DM) + lane;
#pragma unroll
            for (int j = 0; j < 4; ++j) { const f32x4 gv = ((const f32x4*)g_mix_post)[64 * j + lane]; x[k][j] = x[k][j] + y[k][j] * r * gv;
                x1row[64 * j] = (unsigned long long)pk2(x[k][j].x, x[k][j].y) | ((unsigned long long)pk2(x[k][j].z, x[k][j].w) << 32);
                s2 += (x[k][j].x * x[k][j].x + x[k][j].y * x[k][j].y) + (x[k][j].z * x[k][j].z + x[k][j].w * x[k][j].w); }
            const float r2 = 1.f / sqrtf(wave_sum(s2) * (1.f / DM) + EPS);
            if (lane == 0) RS2[m] = r2; }
    } }
#endif
    GRID_BAR();

#ifndef SKIP_P567
    {
        pg8::Gemm g{X1b, Wt_up, pg8::EpiConvGelu::NTILES * 256, NUP, DM}; pg8::StaticOrder S; S.init(pg8::EpiConvGelu::NTILES * 256, NUP, G, bx);
        pg8::EpiConvGelu E{ACTb, conv_w, conv_b, RS2};
        pg8::gemm_phase<pg8::EpiConvGelu, pg8::StaticOrder, true, true>(L, g, S, E);
    }
    GRID_BAR();
    {
        pg8::Gemm g{ACTb, Wt_dn, M, DM, DFF}; pg8::StaticOrder S; S.init(M, DM, G, bx);
        pg8::EpiStore E{Zb, DM};
        pg8::gemm_phase<pg8::EpiStore, pg8::StaticOrder, true, true>(L, g, S, E);
    }
    GRID_BAR();
#endif
#ifndef SKIP_P8
    { int tid8 = threadIdx.x; asm volatile("" : "+v"(tid8)); const int lane = tid8 & 63;
    for (int mb = gw; mb < M; mb += 4 * NGW) {
        f32x4 z[4][4], x1[4][4];
#pragma unroll
        for (int k = 0; k < 4; ++k) { const int m = mb + k * NGW; const v2u* zr = (const v2u*)(Zb + (size_t)m * DM) + lane; const v2u* x1r = (const v2u*)(X1b + (size_t)m * DM) + lane;
#pragma unroll
            for (int j = 0; j < 4; ++j) { const v2u w = __builtin_nontemporal_load(zr + 64 * j); z[k][j] = (f32x4){bflo(w.x), bfhi(w.x), bflo(w.y), bfhi(w.y)}; const v2u xw = __builtin_nontemporal_load(x1r + 64 * j); x1[k][j] = (f32x4){bflo(xw.x), bfhi(xw.x), bflo(xw.y), bfhi(xw.y)}; } }
#pragma unroll
        for (int k = 0; k < 4; ++k) { const int m = mb + k * NGW; float s = 0.f;
#pragma unroll
            for (int j = 0; j < 4; ++j) s += (z[k][j].x * z[k][j].x + z[k][j].y * z[k][j].y) + (z[k][j].z * z[k][j].z + z[k][j].w * z[k][j].w);
            const float r = 1.f / sqrtf(wave_sum(s) * (1.f / DM) + EPS);
            f32x4* orow = (f32x4*)(out + (size_t)m * DM) + lane;
#pragma unroll
            for (int j = 0; j < 4; ++j) { const f32x4 gv = ((const f32x4*)g_ffn_post)[64 * j + lane]; __builtin_nontemporal_store(x1[k][j] + z[k][j] * r * gv, orow + 64 * j); } }
    } }
#endif
}

#undef out
#undef ws
#undef rope
extern "C" void kernel_launch(void* const* d_in, const int* in_sizes, int n_in, void* d_out, int out_size, void* d_ws, size_t ws_size, hipStream_t stream) {
    static int grid = 0;
    if (grid == 0) {
        if (n_in != 16 || out_size != M * DM || ws_size < WS_END) { fprintf(stderr, "kernel_launch: unexpected shapes (n_in %d out %d ws %zu)\n", n_in, out_size, ws_size); grid = -1; return; }
        int dev = 0, cus = 0, per_cu = 0;
        hipGetDevice(&dev); hipDeviceGetAttribute(&cus, hipDeviceAttributeMultiprocessorCount, dev);
        hipFuncSetAttribute((const void*)hymba_fwd, hipFuncAttributeMaxDynamicSharedMemorySize, LDS_BYTES);
        hipOccupancyMaxActiveBlocksPerMultiprocessor(&per_cu, (const void*)hymba_fwd, NTHR, LDS_BYTES);
        (void)hipGetLastError();
        if (per_cu < 1) per_cu = 1;
        grid = cus;
    }
    if (grid < 0) return;
    hipMemsetAsync((char*)d_ws + WS_CTL, 0, CTL_ZERO_BYTES, stream);
    Args a{};
    for (int i = 0; i < 16; ++i) a.in[i] = (const float*)d_in[i];
    a.out = (float*)d_out; a.ws = (unsigned char*)d_ws;
    void* kargs[] = {&a};
    hipError_t e = hipLaunchCooperativeKernel((const void*)hymba_fwd, dim3(grid), dim3(NTHR), kargs, LDS_BYTES, stream);
    if (e != hipSuccess) fprintf(stderr, "cooperative launch failed: %s (grid %d)\n", hipGetErrorString(e), grid);
}
```

```cpp
#include <hip/hip_runtime.h>
#include <hip/hip_cooperative_groups.h>
#include <cstdio>
#include <cstdint>
namespace cg = cooperative_groups;

#ifndef USE_CG_SYNC
#define USE_CG_SYNC 0
#endif

namespace pg8 {
#define PG8_LAS __attribute__((address_space(3)))
typedef unsigned short bf16_t;
typedef short bf16x8 __attribute__((ext_vector_type(8)));
typedef float f32x4 __attribute__((ext_vector_type(4)));
typedef unsigned u32x4 __attribute__((ext_vector_type(4)));
constexpr int BM = 256, BK = 64, HALF = 128, HTB = HALF * BK * 2, STAGE_BYTES = 8 * HTB, NXCD = 8, WGM = 8;

__host__ __device__ __forceinline__ int lds_byte(int r, int c) { const int st = (r >> 4) * 2 + (c >> 5), rr = r & 15, cc = c & 31, ob = rr * 64 + cc * 2; return st * 1024 + (ob ^ (((ob >> 9) & 1) << 5)); }
__host__ __device__ __forceinline__ void stage_rc(int b, int& R, int& C) { const int st = b / 1024, sb = b % 1024, swz = sb ^ (((sb >> 9) & 1) << 5); R = (st >> 1) * 16 + swz / 64; C = (st & 1) * 32 + (swz % 64) / 2; }
__host__ __device__ __forceinline__ int perm32(int rho) { const int n = rho >> 4, i = rho & 15; return 8 * (i >> 2) + 4 * n + (i & 3); }

constexpr int MTOK = 49152, NTOKP = 16384;
constexpr float C2 = 0.125f * 1.4426950408889634f;
struct Unit { int pm, pn; };
struct Gemm { const bf16_t* A; const bf16_t* Bt; int M, N, K; };

struct StaticOrder {
    int nM, nN, nwg, G, c;
    __host__ __device__ void init(int M, int N, int G_, int c_) { nM = M / BM; nN = N / BM; nwg = nM * nN; G = G_; c = c_; }
    __host__ __device__ bool next(int i, Unit& u) const {
        const long L = (long)i * G + c; if (L >= nwg) return false;
        int wgid = (int)L; { const int q = nwg / NXCD, r = nwg % NXCD, xcd = wgid % NXCD, off = wgid / NXCD; wgid = (xcd < r ? xcd * (q + 1) : r * (q + 1) + (xcd - r) * q) + off; }
        const int nig = WGM * nN, gid = wgid / nig, fm = gid * WGM, gsz = (nM - fm) < WGM ? (nM - fm) : WGM;
        u.pm = fm + ((wgid % nig) % gsz); u.pn = (wgid % nig) / gsz; return true;
    }
    __device__ __forceinline__ void a_ready(const Unit&) const {}
    __device__ __forceinline__ void done(const Unit&) const {}
};

__device__ __forceinline__ unsigned cvt_pk_bf16(float lo, float hi) { unsigned r; asm volatile("v_cvt_pk_bf16_f32 %0, %1, %2" : "=v"(r) : "v"(lo), "v"(hi)); return r; }
typedef float f32x2 __attribute__((ext_vector_type(2)));
__device__ __forceinline__ f32x2 gelu_pk(f32x2 v) {
    const f32x2 av = __builtin_elementwise_abs(v), d = av * 0.2316418882f + 1.0f;
    f32x2 t; t.x = __builtin_amdgcn_rcpf(d.x); t.y = __builtin_amdgcn_rcpf(d.y);
    f32x2 q = t * 0.5307027145f + (-0.7265760135f); q = q * t + 0.7107068705f; q = q * t + (-0.142248368f); q = q * t + 0.127414796f; q = q * t;
    const f32x2 s = (v * v) * (-0.72134752044f);
    f32x2 e; e.x = __builtin_amdgcn_exp2f(s.x); e.y = __builtin_amdgcn_exp2f(s.y);
    const f32x2 m = v * (q * e), r = v - m;
    f32x2 o; o.x = v.x < 0.f ? m.x : r.x; o.y = v.y < 0.f ? m.y : r.y; return o;
}

struct EpiStore {
    static constexpr bool PERM = true, AFTER_DRAIN = false; static constexpr bool NEEDS_LDS = false; static __device__ __forceinline__ int row0(int pm) { return pm * BM; } static constexpr int MIDK_T = 0;
    bf16_t* O; int ldc;
    __device__ __forceinline__ void operator()(const f32x4 (&acc)[2][2][4][2], const Unit& u, int wr, int wc, int fr, int fq) const {
        const int lane = fq * 16 + fr, srcl = 16 * (lane & 3) + (lane >> 2), r2 = lane >> 2, c2 = lane & 3;
        const int row0 = u.pm * BM + wr * 64 + r2; const int col0 = u.pn * BM + wc * 32 + 8 * c2;
#pragma unroll
        for (int ai = 0; ai < 2; ++ai)
#pragma unroll
            for (int m = 0; m < 4; ++m) { bf16_t* rowp = O + (size_t)(row0 + ai * HALF + m * 16) * ldc + col0;
#pragma unroll
                for (int bj = 0; bj < 2; ++bj) { const f32x4 v0 = acc[ai][bj][m][0], v1 = acc[ai][bj][m][1];
                    u32x4 w; w.x = __shfl(cvt_pk_bf16(v0[0], v0[1]), srcl); w.y = __shfl(cvt_pk_bf16(v0[2], v0[3]), srcl); w.z = __shfl(cvt_pk_bf16(v1[0], v1[1]), srcl); w.w = __shfl(cvt_pk_bf16(v1[2], v1[3]), srcl);
                    *(u32x4*)(rowp + bj * HALF) = w; } }
    }
};

struct EpiOutProj {
    static constexpr bool PERM = true, AFTER_DRAIN = false; static constexpr bool NEEDS_LDS = false; static __device__ __forceinline__ int row0(int pm) { return pm * BM; } static constexpr int MIDK_T = 4;
    bf16_t* O; int ldc; const float* ssq;
    __device__ __forceinline__ float sattn(int row) const { const f32x4* p = (const f32x4*)(ssq + (size_t)row * 12); const f32x4 a = p[0], b = p[1], c = p[2];
        return sqrtf((((a[0] + a[1]) + (a[2] + a[3])) + ((b[0] + b[1]) + (b[2] + b[3])) + ((c[0] + c[1]) + (c[2] + c[3]))) * (1.f / 768.f) + 1e-6f); }
    __device__ __forceinline__ void midk(f32x4 (&acc)[2][2][4][2], const Unit& u, int wr, int) const {
        int tl = threadIdx.x; asm volatile("" : "+v"(tl));
        const int row0 = u.pm * BM + wr * 64 + (tl & 15);
#pragma unroll
        for (int ai = 0; ai < 2; ++ai)
#pragma unroll
            for (int m = 0; m < 4; ++m) { const float sv = sattn(row0 + ai * HALF + m * 16);
#pragma unroll
                for (int bj = 0; bj < 2; ++bj)
#pragma unroll
                    for (int n = 0; n < 2; ++n) acc[ai][bj][m][n] = acc[ai][bj][m][n] * sv; }
    }
    __device__ __forceinline__ void operator()(const f32x4 (&acc)[2][2][4][2], const Unit& u, int wr, int wc, int fr, int fq) const {
        const int row0 = u.pm * BM + wr * 64 + fr; const int col0 = u.pn * BM + wc * 32 + 8 * fq;
#pragma unroll
        for (int ai = 0; ai < 2; ++ai)
#pragma unroll
            for (int m = 0; m < 4; ++m) { const int row = row0 + ai * HALF + m * 16; const float r = 1.f / sattn(row); bf16_t* rowp = O + (size_t)row * ldc + col0;
#pragma unroll
                for (int bj = 0; bj < 2; ++bj) { const f32x4 v0 = acc[ai][bj][m][0] * r, v1 = acc[ai][bj][m][1] * r;
                    u32x4 w; w.x = cvt_pk_bf16(v0[0], v0[1]); w.y = cvt_pk_bf16(v0[2], v0[3]); w.z = cvt_pk_bf16(v1[0], v1[1]); w.w = cvt_pk_bf16(v1[2], v1[3]);
                    *(u32x4*)(rowp + bj * HALF) = w; } }
    }
};

struct EpiConvGelu {
    static constexpr bool PERM = true, AFTER_DRAIN = false, NEEDS_LDS = true; static constexpr int MIDK_T = 0;
    static constexpr int NTILES = (MTOK + 253) / 254;
    bf16_t* ACT; const float* cw; const float* cb; const float* rs;
    static __device__ __forceinline__ int row0(int pm) { return 254 * pm - 1; }
    __device__ __forceinline__ void run(f32x4 (&acc)[2][2][4][2], const Unit& u, int wr, int wc, PG8_LAS unsigned char* xbuf) const {
        int tl = threadIdx.x; asm volatile("" : "+v"(tl));
        const int lane = tl & 63, fr = lane & 15, fq = lane >> 4;
        const int rb = 254 * u.pm - 1;
        const int colw = 32 * wc + 8 * fq, ch0 = 128 * u.pn + colw;
        PG8_LAS float* X = (PG8_LAS float*)xbuf;
#pragma unroll
        for (int ai = 0; ai < 2; ++ai)
#pragma unroll
            for (int m = 0; m < 4; ++m) { int row = rb + 128 * ai + 64 * wr + 16 * m + fr; row = row < 0 ? 0 : (row > MTOK - 1 ? MTOK - 1 : row); const float rr = rs[row];
#pragma unroll
                for (int bj = 0; bj < 2; ++bj)
#pragma unroll
                    for (int n = 0; n < 2; ++n) acc[ai][bj][m][n] = acc[ai][bj][m][n] * rr; }
#pragma unroll
        for (int ai = 0; ai < 2; ++ai) { const int c = 2 * ai + wr;
#pragma unroll
            for (int bj = 0; bj < 2; ++bj)
#pragma unroll
                for (int n = 0; n < 2; ++n) { const int col = 128 * bj + colw + 4 * n;
                    if (fr == 0) *(PG8_LAS f32x4*)(X + (c * 2 + 0) * 256 + col) = acc[ai][bj][0][n];
                    if (fr == 15) *(PG8_LAS f32x4*)(X + (c * 2 + 1) * 256 + col) = acc[ai][bj][3][n]; } }
        asm volatile("s_waitcnt lgkmcnt(0)" ::: "memory"); __builtin_amdgcn_s_barrier(); asm volatile("" ::: "memory");
        const int lo_ = rb, hi_ = rb + 255, lg_ = hi_ < NTOKP ? 11 : 14;
        const bool hasb = (lo_ < NTOKP && hi_ >= NTOKP) || (((hi_ + 1) >> lg_) >= ((lo_ + (1 << lg_) - 1) >> lg_));
        if (hasb) body<true>(acc, u, wr, wc, X, fr, fq, rb, colw, ch0); else body<false>(acc, u, wr, wc, X, fr, fq, rb, colw, ch0);
    }
    template <bool HASB>
    __device__ __forceinline__ void body(f32x4 (&acc)[2][2][4][2], const Unit& u, int wr, int wc, PG8_LAS float* X, int fr, int fq, int rb, int colw, int ch0) const {
        typedef unsigned u32x2 __attribute__((ext_vector_type(2)));
        u32x2 stash[2][4];
#pragma unroll
        for (int n = 0; n < 2; ++n) {
            f32x4 wg[3], wv[3];
#pragma unroll
            for (int t3 = 0; t3 < 3; ++t3) { wg[t3] = *(const f32x4*)(cw + (size_t)t3 * 5632 + ch0 + 4 * n); wv[t3] = *(const f32x4*)(cw + (size_t)t3 * 5632 + 2816 + ch0 + 4 * n); }
            const f32x4 bg = *(const f32x4*)(cb + ch0 + 4 * n), bv = *(const f32x4*)(cb + 2816 + ch0 + 4 * n);
#pragma unroll
            for (int ai = 0; ai < 2; ++ai) { const int c = 2 * ai + wr;
                f32x4 pr[2], nx[2];
#pragma unroll
                for (int bj = 0; bj < 2; ++bj) { const int col = 128 * bj + colw + 4 * n;
                    pr[bj] = *(const PG8_LAS f32x4*)(X + ((c > 0 ? c - 1 : 0) * 2 + 1) * 256 + col); nx[bj] = *(const PG8_LAS f32x4*)(X + ((c < 3 ? c + 1 : 3) * 2 + 0) * 256 + col); }
#pragma unroll
                for (int m = 0; m < 4; ++m) {
                    const int rt = 128 * ai + 64 * wr + 16 * m + fr, row = rb + rt;
                    const int Sm1 = row < NTOKP ? 2047 : 16383, t = row & Sm1;
                    const bool z_up = t == 0, z_dn = t == Sm1;
                    f32x4 y[2];
#pragma unroll
                    for (int bj = 0; bj < 2; ++bj) { const f32x4 x = acc[ai][bj][m][n];
                        const f32x4 srcu = m > 0 ? acc[ai][bj][m > 0 ? m - 1 : 0][n] : pr[bj], srcd = m < 3 ? acc[ai][bj][m < 3 ? m + 1 : 3][n] : nx[bj];
                        f32x4 up, dn;
#pragma unroll
                        for (int e = 0; e < 4; ++e) { const float su = fr == 15 ? srcu[e] : x[e], sd = fr == 0 ? srcd[e] : x[e];
                            const float gu = __builtin_bit_cast(float, __builtin_amdgcn_update_dpp(0, __builtin_bit_cast(int, su), 0x121, 0xF, 0xF, false));
                            const float gd = __builtin_bit_cast(float, __builtin_amdgcn_update_dpp(0, __builtin_bit_cast(int, sd), 0x12F, 0xF, 0xF, false));
                            up[e] = (HASB && z_up) ? 0.f : gu; dn[e] = (HASB && z_dn) ? 0.f : gd; }
                        y[bj] = bj ? (bv + wv[0] * up + wv[1] * x + wv[2] * dn) : (bg + wg[0] * up + wg[1] * x + wg[2] * dn); }
                    const f32x2 g0 = gelu_pk((f32x2){y[0][0], y[0][1]}), g1 = gelu_pk((f32x2){y[0][2], y[0][3]});
                    u32x2 w; w.x = cvt_pk_bf16(g0.x * y[1][0], g0.y * y[1][1]); w.y = cvt_pk_bf16(g1.x * y[1][2], g1.y * y[1][3]);
                    if (n == 0) stash[ai][m] = w;
                    else if (rt >= 1 && rt <= 254 && row < MTOK) { u32x4 w4; w4.x = stash[ai][m].x; w4.y = stash[ai][m].y; w4.z = w.x; w4.w = w.y; *(u32x4*)(ACT + (size_t)row * 2816 + ch0) = w4; }
                }
            }
        }
    }
};

struct EpiProj {
    static constexpr bool PERM = true, AFTER_DRAIN = false; static constexpr bool NEEDS_LDS = false; static __device__ __forceinline__ int row0(int pm) { return pm * BM; } static constexpr int MIDK_T = 0;
    bf16_t *P, *Q; const float* rope; const float* rs;
    __device__ __forceinline__ void operator()(const f32x4 (&acc)[2][2][4][2], const Unit& u, int wr, int wc, int fr, int fq) const {
        const int row0 = u.pm * BM + wr * 64 + fr;
        if (u.pn == 0) {
            const int col0 = wc * 32 + 8 * fq;
#pragma unroll
            for (int ai = 0; ai < 2; ++ai)
#pragma unroll
                for (int m = 0; m < 4; ++m) { bf16_t* rowp = P + (size_t)(row0 + ai * HALF + m * 16) * 256 + col0; const float rr = rs[row0 + ai * HALF + m * 16];
#pragma unroll
                    for (int bj = 0; bj < 2; ++bj) { const f32x4 v0 = acc[ai][bj][m][0] * rr, v1 = acc[ai][bj][m][1] * rr;
                        u32x4 w; w.x = cvt_pk_bf16(v0[0], v0[1]); w.y = cvt_pk_bf16(v0[2], v0[3]); w.z = cvt_pk_bf16(v1[0], v1[1]); w.w = cvt_pk_bf16(v1[2], v1[3]);
                        *(u32x4*)(rowp + bj * HALF) = w; } }
        } else {
            const int kind = (u.pn - 1) / 3, hb = ((u.pn - 1) % 3) * 4;
            bf16_t* T = Q + (size_t)kind * ((size_t)MTOK * 768);
            const bool do_rope = (kind < 2) && ((wc & 1) == 0);
            const float sc = kind == 0 ? C2 : 1.0f;
            const float sgn = fq == 0 ? -1.0f : 1.0f;
            const int dim0 = 32 * (wc & 1) + 8 * fq;
#pragma unroll
            for (int ai = 0; ai < 2; ++ai)
#pragma unroll
                for (int m = 0; m < 4; ++m) { const int row = row0 + ai * HALF + m * 16; const int t = row < NTOKP ? (row & 2047) : (row & 16383); const float rr = rs[row];
#pragma unroll
                    for (int bj = 0; bj < 2; ++bj) { f32x4 v0 = acc[ai][bj][m][0] * rr, v1 = acc[ai][bj][m][1] * rr;
                        if (do_rope) {
                            f32x4 p0, p1;
#pragma unroll
                            for (int j = 0; j < 4; ++j) {
                                auto a0 = __builtin_amdgcn_permlane16_swap(__float_as_uint(v0[j]), __float_as_uint(v0[j]), false, false);
                                auto a1 = __builtin_amdgcn_permlane16_swap(__float_as_uint(v1[j]), __float_as_uint(v1[j]), false, false);
                                p0[j] = __uint_as_float((fq & 1) ? a0[0] : a0[1]); p1[j] = __uint_as_float((fq & 1) ? a1[0] : a1[1]); }
                            if (fq < 2) { const f32x4 c0 = *(const f32x4*)(rope + t * 16), c1 = *(const f32x4*)(rope + t * 16 + 4), s0 = *(const f32x4*)(rope + t * 16 + 8), s1 = *(const f32x4*)(rope + t * 16 + 12);
                                v0 = v0 * c0 + (p0 * s0) * sgn; v1 = v1 * c1 + (p1 * s1) * sgn; }
                        }
                        v0 = v0 * sc; v1 = v1 * sc;
                        const int head = hb + 2 * bj + (wc >> 1);
                        u32x4 w; w.x = cvt_pk_bf16(v0[0], v0[1]); w.y = cvt_pk_bf16(v0[2], v0[3]); w.z = cvt_pk_bf16(v1[0], v1[1]); w.w = cvt_pk_bf16(v1[2], v1[3]);
                        *(u32x4*)(T + ((size_t)head * MTOK + row) * 64 + dim0) = w; } }
        }
    }
};

template <class Epi, class Sched, bool ALIGN_EPI = false, bool SP2 = false>
__device__ __forceinline__ void gemm_phase(PG8_LAS unsigned char* lds, const Gemm g, const Sched& S, const Epi& E) {
    int tid = threadIdx.x; asm volatile("" : "+v"(tid));
    const int wid = __builtin_amdgcn_readfirstlane(tid >> 6), lane = tid & 63, wr = wid >> 2, wc = wid & 3, fr = lane & 15, fq = lane >> 4;
    const int K = g.K, nt = K / BK;
    unsigned voffA[2], voffB[2];
#pragma unroll
    for (int i = 0; i < 2; ++i) { int R, C; stage_rc(tid * 16 + i * 8192, R, C); const int Rb = Epi::PERM ? ((R & ~31) + perm32(R & 31)) : R;
        voffA[i] = (unsigned)(R * K + C) * 2u; voffB[i] = (unsigned)(Rb * K + C) * 2u; }
    const size_t kstep = (size_t)(BK * 2);
    const size_t hstep = (size_t)HALF * K * 2;
    const size_t tstep = 2 * hstep;
    const unsigned ldsw = (unsigned)wid * 1024u;
    const int aoff = lds_byte(wr * 64 + fr, fq * 8), boff = lds_byte(wc * 32 + fr, fq * 8);
#define PG8_SA(b, h) (((b) * 2 + (h)) * HTB)
#define PG8_SB(b, h) ((4 + (b) * 2 + (h)) * HTB)
#define PG8_STAGE(bufoff, gbase, voff) do { _Pragma("unroll") for (int _i = 0; _i < 2; ++_i) \
        __builtin_amdgcn_global_load_lds((const unsigned*)((const char*)(gbase) + (voff)[_i]), (PG8_LAS unsigned*)(lds + (bufoff) + ldsw + _i * 8192), 16, 0, 0); } while (0)
#define PG8_LDA(dst, b, h) do { _Pragma("unroll") for (int m = 0; m < 4; ++m) _Pragma("unroll") for (int k = 0; k < 2; ++k) dst[m][k] = *(const PG8_LAS bf16x8*)(lds + PG8_SA(b, h) + aoff + m * 2048 + k * 1024); } while (0)
#define PG8_LDB(dst, b, h) do { _Pragma("unroll") for (int n = 0; n < 2; ++n) _Pragma("unroll") for (int k = 0; k < 2; ++k) dst[n][k] = *(const PG8_LAS bf16x8*)(lds + PG8_SB(b, h) + boff + n * 2048 + k * 1024); } while (0)
#define PG8_MMA(ai, bj, At, Bt) do { __builtin_amdgcn_s_setprio(1); _Pragma("unroll") for (int m = 0; m < 4; ++m) _Pragma("unroll") for (int n = 0; n < 2; ++n) _Pragma("unroll") for (int k = 0; k < 2; ++k) \
        acc[ai][bj][m][n] = __builtin_amdgcn_mfma_f32_16x16x32_bf16(Bt[n][k], At[m][k], acc[ai][bj][m][n], 0, 0, 0); __builtin_amdgcn_s_setprio(0); } while (0)
#define PG8_WAIT_V(n) asm volatile("s_waitcnt vmcnt(" #n ")" ::: "memory")
#define PG8_WAIT_L(n) asm volatile("s_waitcnt lgkmcnt(" #n ")" ::: "memory")
#define PG8_BAR __builtin_amdgcn_s_barrier()
#define PG8_SCHED __builtin_amdgcn_sched_barrier(0)
    Unit cur, nxt; int ui = 0;
    if (!S.next(0, cur)) return;
    f32x4 acc[2][2][4][2];
#pragma unroll
    for (int a = 0; a < 2; ++a)
#pragma unroll
        for (int b = 0; b < 2; ++b)
#pragma unroll
            for (int m = 0; m < 4; ++m)
#pragma unroll
                for (int n = 0; n < 2; ++n) acc[a][b][m][n] = (f32x4){0.f, 0.f, 0.f, 0.f};
    bf16x8 At[4][2], B0[2][2], B1[2][2];
    const long rstep = (long)K * 2;
    const char* cA = (const char*)g.A + (long)Epi::row0(cur.pm) * rstep; const char* cB = (const char*)g.Bt + (size_t)cur.pn * tstep;
    S.a_ready(cur);
    if constexpr (SP2) {
        PG8_STAGE(PG8_SB(0, 0), cB, voffB); PG8_STAGE(PG8_SB(0, 1), cB + hstep, voffB); PG8_STAGE(PG8_SA(0, 0), cA, voffA); PG8_STAGE(PG8_SA(0, 1), cA + hstep, voffA);
        if (wr == 1) PG8_BAR;
        PG8_WAIT_V(2); PG8_BAR;
        PG8_STAGE(PG8_SB(1, 0), cB + kstep, voffB); PG8_STAGE(PG8_SA(1, 0), cA + kstep, voffA); PG8_STAGE(PG8_SB(1, 1), cB + hstep + kstep, voffB);
        PG8_WAIT_V(6); PG8_BAR;
    } else {
        PG8_STAGE(PG8_SB(0, 0), cB, voffB); PG8_STAGE(PG8_SA(0, 0), cA, voffA); PG8_STAGE(PG8_SB(0, 1), cB + hstep, voffB); PG8_STAGE(PG8_SA(0, 1), cA + hstep, voffA);
        if (wr == 1) PG8_BAR;
        PG8_WAIT_V(4); PG8_BAR;
        PG8_STAGE(PG8_SB(1, 0), cB + kstep, voffB); PG8_STAGE(PG8_SA(1, 0), cA + kstep, voffA); PG8_STAGE(PG8_SB(1, 1), cB + hstep + kstep, voffB);
        PG8_WAIT_V(6); PG8_BAR;
    }
    for (;;) {
        const bool has_next = S.next(ui + 1, nxt);
        const char* nA = has_next ? (const char*)g.A + (long)Epi::row0(nxt.pm) * rstep : cA; const char* nB = has_next ? (const char*)g.Bt + (size_t)nxt.pn * tstep : cB;
        for (int t = 0; t < nt; t += 2) {
            const bool last = (t == nt - 2);
            const char* a1 = cA + (size_t)(t + 1) * kstep;
            const char* a2 = last ? nA : cA + (size_t)(t + 2) * kstep; const char* b2 = last ? nB : cB + (size_t)(t + 2) * kstep;
            const char* a3 = a2 + kstep; const char* b3 = b2 + kstep;
            if (last && has_next) S.a_ready(nxt);
            if constexpr (Epi::MIDK_T > 0) { if (t == Epi::MIDK_T) E.midk(acc, cur, wr, fr); }
            if constexpr (SP2) {
            PG8_LDB(B0, 0, 0); PG8_LDB(B1, 0, 1); PG8_SCHED; PG8_LDA(At, 0, 0); PG8_STAGE(PG8_SA(1, 1), a1 + hstep, voffA);
            PG8_WAIT_V(8); PG8_WAIT_L(0); PG8_BAR; PG8_MMA(0, 0, At, B0); PG8_MMA(0, 1, At, B1); PG8_BAR; PG8_SCHED;
            PG8_LDA(At, 0, 1); PG8_STAGE(PG8_SB(0, 0), b2, voffB); PG8_STAGE(PG8_SB(0, 1), b2 + hstep, voffB); PG8_STAGE(PG8_SA(0, 0), a2, voffA);
            PG8_WAIT_V(8); PG8_WAIT_L(0); PG8_BAR; PG8_MMA(1, 0, At, B0); PG8_MMA(1, 1, At, B1); PG8_BAR; PG8_SCHED;
            PG8_LDB(B0, 1, 0); PG8_LDB(B1, 1, 1); PG8_SCHED; PG8_LDA(At, 1, 0); PG8_STAGE(PG8_SA(0, 1), a2 + hstep, voffA);
            PG8_WAIT_V(8); PG8_WAIT_L(0); PG8_BAR; PG8_MMA(0, 0, At, B0); PG8_MMA(0, 1, At, B1); PG8_BAR; PG8_SCHED;
            PG8_LDA(At, 1, 1); PG8_STAGE(PG8_SB(1, 0), b3, voffB); PG8_STAGE(PG8_SB(1, 1), b3 + hstep, voffB); PG8_STAGE(PG8_SA(1, 0), a3, voffA);
            PG8_WAIT_V(8); PG8_WAIT_L(0); PG8_BAR; PG8_MMA(1, 0, At, B0); PG8_MMA(1, 1, At, B1); PG8_BAR; PG8_SCHED;
            } else {
            PG8_LDB(B0, 0, 0); PG8_SCHED; PG8_LDA(At, 0, 0); PG8_STAGE(PG8_SA(1, 1), a1 + hstep, voffA);
            PG8_WAIT_L(8); PG8_BAR; PG8_WAIT_L(0); PG8_MMA(0, 0, At, B0); PG8_BAR; PG8_SCHED;
            PG8_LDB(B1, 0, 1); PG8_STAGE(PG8_SB(0, 0), b2, voffB);
            PG8_BAR; PG8_WAIT_L(0); PG8_MMA(0, 1, At, B1); PG8_BAR;
            PG8_LDA(At, 0, 1); PG8_STAGE(PG8_SA(0, 0), a2, voffA);
            PG8_BAR; PG8_WAIT_L(0); PG8_MMA(1, 0, At, B0); PG8_BAR; PG8_SCHED;
            PG8_STAGE(PG8_SB(0, 1), b2 + hstep, voffB);
            PG8_WAIT_V(6); PG8_BAR; PG8_MMA(1, 1, At, B1); PG8_BAR;
            PG8_LDB(B0, 1, 0); PG8_SCHED; PG8_LDA(At, 1, 0); PG8_STAGE(PG8_SA(0, 1), a2 + hstep, voffA);
            PG8_WAIT_L(8); PG8_BAR; PG8_WAIT_L(0); PG8_MMA(0, 0, At, B0); PG8_BAR; PG8_SCHED;
            PG8_LDB(B1, 1, 1); PG8_STAGE(PG8_SB(1, 0), b3, voffB);
            PG8_BAR; PG8_WAIT_L(0); PG8_MMA(0, 1, At, B1); PG8_BAR;
            PG8_LDA(At, 1, 1); PG8_STAGE(PG8_SA(1, 0), a3, voffA);
            PG8_BAR; PG8_WAIT_L(0); PG8_MMA(1, 0, At, B0); PG8_BAR; PG8_SCHED;
            PG8_STAGE(PG8_SB(1, 1), b3 + hstep, voffB);
            PG8_WAIT_V(6); PG8_BAR; PG8_MMA(1, 1, At, B1); PG8_BAR;
            }
        }
        if constexpr (ALIGN_EPI) { if (wr == 0) PG8_BAR; }
        if constexpr (!Epi::AFTER_DRAIN) { if constexpr (Epi::NEEDS_LDS) E.run(acc, cur, wr, wc, lds + 132096); else E(acc, cur, wr, wc, fr, fq); S.done(cur); }
        if (!has_next) break;
#pragma unroll
        for (int a = 0; a < 2; ++a)
#pragma unroll
            for (int b = 0; b < 2; ++b)
#pragma unroll
                for (int m = 0; m < 4; ++m)
#pragma unroll
                    for (int n = 0; n < 2; ++n) acc[a][b][m][n] = (f32x4){0.f, 0.f, 0.f, 0.f};
        cur = nxt; cA = nA; cB = nB; ++ui;
        if constexpr (ALIGN_EPI) { if (wr == 1) PG8_BAR; }
    }
    PG8_WAIT_V(0);
    if constexpr (!ALIGN_EPI) { if (wr == 0) PG8_BAR; }
    PG8_BAR;
#undef PG8_SA
#undef PG8_SB
#undef PG8_STAGE
#undef PG8_LDA
#undef PG8_LDB
#undef PG8_MMA
#undef PG8_WAIT_V
#undef PG8_WAIT_L
#undef PG8_BAR
#undef PG8_SCHED
}
}

constexpr int NWAVES = 8, NTHR = 512;
constexpr int DM = 1024, M = 49152, NTP = 16384, SP = 2048, SS = 16384;
constexpr int NIN = 2560, DFF = 2816, NUP = 5632, NH = 12, HD = 64, PW = 256;
constexpr float EPS = 1e-6f;

constexpr size_t MiB = 1u << 20;
constexpr size_t WS_CTL = 0, CTL_ZERO_BYTES = 65536;
constexpr size_t WS_ROPE = 1 * MiB;
constexpr size_t WS_WIN = 2 * MiB, WS_WOUT = 8 * MiB, WS_WUP = 10 * MiB, WS_WDN = 21 * MiB;
constexpr size_t WS_SSQ = 27 * MiB;
constexpr size_t WS_RS1 = 30 * MiB, WS_RS2 = 31 * MiB;
constexpr size_t WS_H = 32 * MiB;
constexpr size_t WS_P = 128 * MiB, WS_Q = 152 * MiB, WS_K = 224 * MiB, WS_V = 296 * MiB, WS_Y = 128 * MiB;
constexpr size_t WS_X1 = 392 * MiB;
constexpr size_t WS_ACT = 128 * MiB, WS_Z = 32 * MiB, WS_END = 489 * MiB;
constexpr int CW_BAR = 4096;

constexpr int RING_BYTES = 131072, LDS_BYTES = 147456, LDSCTL_OFF = LDS_BYTES - 1024, MISC_OFF = LDSCTL_OFF + 320;

#define GAS __attribute__((address_space(1)))
#define LAS __attribute__((address_space(3)))
typedef unsigned short bf16;
typedef unsigned v4u __attribute__((ext_vector_type(4)));
typedef unsigned v2u __attribute__((ext_vector_type(2)));
typedef float f32x4 __attribute__((ext_vector_type(4)));
#define LDS_WAIT() asm volatile("s_waitcnt lgkmcnt(0)" ::: "memory")

__device__ __forceinline__ unsigned f2bf(float f) { unsigned u = __builtin_bit_cast(unsigned, f); return (u + 0x7fffu + ((u >> 16) & 1u)) >> 16; }
__device__ __forceinline__ unsigned pk2(float lo, float hi) { return f2bf(lo) | (f2bf(hi) << 16); }
__device__ __forceinline__ float bflo(unsigned w) { return __builtin_bit_cast(float, w << 16); }
__device__ __forceinline__ float bfhi(unsigned w) { return __builtin_bit_cast(float, w & 0xffff0000u); }

#define XB_TMO      128
#define XB_XCNT(j)  (256  + 64 * (j))
#define XB_XSUB(j)  (1280 + 64 * (j))
#define XB_XGEN(j)  (2304 + 64 * (j))
#define XB_TOP      3328
#define XB_TOPGEN   3392
#define XCD_BAR_WORDS 3456
#define XB_SPIN_CAP (1u << 18)
__device__ __forceinline__ unsigned xb_ld(unsigned* p)              { return __hip_atomic_load(p, __ATOMIC_RELAXED, __HIP_MEMORY_SCOPE_AGENT); }
__device__ __forceinline__ unsigned xb_add(unsigned* p, unsigned v) { return __hip_atomic_fetch_add(p, v, __ATOMIC_RELAXED, __HIP_MEMORY_SCOPE_AGENT); }
__device__ __forceinline__ unsigned xb_xcc_id() { return (unsigned)__builtin_amdgcn_s_getreg((3 << 11) | 20) & 0xFu; }
#define XB_SPIN(cond, bar) do { unsigned _sp = 0; while (cond) { __builtin_amdgcn_s_sleep(1); \
    if ((++_sp & 255u) == 0u) { if (xb_ld(&(bar)[XB_TMO])) break; if (_sp > XB_SPIN_CAP) { atomicAdd(&(bar)[XB_TMO], 1u); break; } } } } while (0)
struct XcdBarrier { unsigned* bar; unsigned x; volatile LAS unsigned* st; };
__device__ __forceinline__ XcdBarrier xcd_barrier_post(unsigned* bar, volatile LAS unsigned* st) {
    XcdBarrier b; b.bar = bar; b.x = xb_xcc_id(); b.st = st;
    if (threadIdx.x == 0) (void)xb_add(&bar[XB_XCNT(b.x)], 1u);
    return b;
}
__device__ __forceinline__ void xcd_barrier_complete(unsigned* bar, unsigned x, unsigned& nloc, unsigned& nx) {
    const unsigned G = gridDim.x * gridDim.y * gridDim.z;
    unsigned sum, cnt, mine, sp = 0u;
    for (;;) {
        sum = 0u; cnt = 0u; mine = 0u;
#pragma unroll
        for (unsigned j = 0; j < 16; ++j) { const unsigned c = xb_ld(&bar[XB_XCNT(j)]); sum += c; cnt += (c > 0u) ? 1u : 0u; mine = (j == x) ? c : mine; }
        if (sum == G) break;
        __builtin_amdgcn_s_sleep(1);
        if ((++sp & 255u) == 0u) { if (xb_ld(&bar[XB_TMO])) break; if (sp > XB_SPIN_CAP) { atomicAdd(&bar[XB_TMO], 1u); break; } }
    }
    nloc = mine > 0u ? mine : 1u; nx = cnt > 0u ? cnt : 1u;
}
__device__ __forceinline__ void xcd_barrier(const XcdBarrier& b) {
    asm volatile("s_waitcnt vmcnt(0)" ::: "memory");
    __syncthreads();
    if (threadIdx.x == 0) {
        unsigned* bar = b.bar;
        __builtin_amdgcn_s_waitcnt(0);
        unsigned nloc = b.st[0], nx = b.st[1];
        if (nloc == 0u) { xcd_barrier_complete(bar, b.x, nloc, nx); b.st[0] = nloc; b.st[1] = nx; }
        const unsigned old = xb_add(&bar[XB_XSUB(b.x)], 1u);
        const unsigned gen = old / nloc;
        if (old + 1u == (gen + 1u) * nloc) {
            __builtin_amdgcn_fence(__ATOMIC_RELEASE, "agent");
            asm volatile("s_waitcnt vmcnt(0)" ::: "memory");
            const unsigned og = xb_add(&bar[XB_TOP], 1u);
            const unsigned tg = og / nx;
            if (og + 1u == (tg + 1u) * nx) xb_add(&bar[XB_TOPGEN], 1u);
            else XB_SPIN(xb_ld(&bar[XB_TOPGEN]) == tg, bar);
            __builtin_amdgcn_fence(__ATOMIC_ACQUIRE, "agent");
            xb_add(&bar[XB_XGEN(b.x)], 1u);
            asm volatile("s_waitcnt vmcnt(0)" ::: "memory");
        } else {
            XB_SPIN(xb_ld(&bar[XB_XGEN(b.x)]) == gen, bar);
            __builtin_amdgcn_fence(__ATOMIC_ACQUIRE, "agent");
            asm volatile("s_waitcnt vmcnt(0)" ::: "memory");
        }
    }
    __syncthreads();
}

__device__ __forceinline__ float wave_sum(float v) {
#pragma unroll
    for (int o = 1; o < 64; o <<= 1) v += __shfl_xor(v, o);
    return v;
}
__device__ __forceinline__ const float* xrow_ptr(const float* xp, const float* xs, int m) { return m < NTP ? xp + (size_t)m * DM : xs + (size_t)(m - NTP) * DM; }
__device__ __forceinline__ void seq_of(int m, int& s0, int& S) { if (m < NTP) { s0 = m & ~(SP - 1); S = SP; } else { s0 = NTP + ((m - NTP) & ~(SS - 1)); S = SS; } }

__device__ __forceinline__ void p0_transpose_item(const float* W, int K, int N, bf16* WT, LAS float* scr, int item, int lane, const float* ga = nullptr, const float* gb = nullptr, int gsplit = 0, bool upmap = false) {
    const int nblk = N / 32, kb = item / nblk, nb = item % nblk, k0 = 64 * kb, n0 = 32 * nb;
    int nd0 = n0; if (upmap) { const int bj = n0 >= DFF ? 1 : 0, ch = n0 - DFF * bj; nd0 = 256 * (ch >> 7) + 128 * bj + (ch & 127); }
#pragma unroll 8
    for (int i = 0; i < 32; ++i) { const int kk = 2 * i + (lane >> 5); float wv = __builtin_nontemporal_load(W + (size_t)(k0 + kk) * N + n0 + (lane & 31));
        if (ga) { const int k = k0 + kk; wv *= (k < gsplit ? ga[k] : gb[k - gsplit]); }
        scr[kk * 33 + (lane & 31)] = wv; }
    LDS_WAIT(); asm volatile("" ::: "memory");
    const int c = lane & 7;
#pragma unroll
    for (int j = 0; j < 4; ++j) { const int n = (lane >> 3) + 8 * j; const LAS float* s = scr + (8 * c) * 33 + n;
        v4u o; o.x = pk2(s[0 * 33], s[1 * 33]); o.y = pk2(s[2 * 33], s[3 * 33]); o.z = pk2(s[4 * 33], s[5 * 33]); o.w = pk2(s[6 * 33], s[7 * 33]);
        *(v4u*)(WT + (size_t)(nd0 + n) * K + k0 + 8 * c) = o; }
    LDS_WAIT(); asm volatile("" ::: "memory");
}

__constant__ double ROPE_REV[8] = {0.15915494309189535, 0.03086376340470123, 0.005985185712713705, 0.001160663641240061,
                                   0.00022507907903927653, 4.364795279280289e-05, 8.464330808241401e-06, 1.6414262627950345e-06};

__device__ __forceinline__ float rows_max(float v) {
    auto a = __builtin_amdgcn_permlane16_swap(__float_as_uint(v), __float_as_uint(v), false, false); v = fmaxf(__uint_as_float(a[0]), __uint_as_float(a[1]));
    auto b = __builtin_amdgcn_permlane32_swap(__float_as_uint(v), __float_as_uint(v), false, false); return fmaxf(__uint_as_float(b[0]), __uint_as_float(b[1]));
}
__device__ __forceinline__ float rows_sum(float v) {
    auto a = __builtin_amdgcn_permlane16_swap(__float_as_uint(v), __float_as_uint(v), false, false); v = __uint_as_float(a[0]) + __uint_as_float(a[1]);
    auto b = __builtin_amdgcn_permlane32_swap(__float_as_uint(v), __float_as_uint(v), false, false); return __uint_as_float(b[0]) + __uint_as_float(b[1]);
}
struct Args { const float* in[16]; float* out; unsigned char* ws; };

__global__ void __launch_bounds__(NTHR, 2) hymba_fwd(Args args) {
    extern __shared__ __attribute__((aligned(16))) unsigned char lds[];
    cg::grid_group grid = cg::this_grid();
    LAS unsigned char* L = (LAS unsigned char*)lds;
    const int tid = threadIdx.x, lane = tid & 63, wave = __builtin_amdgcn_readfirstlane(tid >> 6);
    const int G = gridDim.x, bx = blockIdx.x;
    const int vcu = (G % 8 == 0) ? (bx % 8) * (G / 8) + bx / 8 : bx;
    const int gw = vcu * NWAVES + wave, NGW = G * NWAVES;
#define xp (args.in[0])
#define xs (args.in[1])
#define g_mix_pre (args.in[2])
#define g_mix_post (args.in[3])
#define w_in (args.in[4])
#define pool_w (args.in[5])
#define pool_scale (args.in[6])
#define g_pool_out (args.in[7])
#define g_attn_out (args.in[8])
#define w_out (args.in[9])
#define g_ffn_pre (args.in[10])
#define g_ffn_post (args.in[11])
#define w_up (args.in[12])
#define conv_w (args.in[13])
#define conv_b (args.in[14])
#define w_down (args.in[15])
#define out (args.out)
#define ws (args.ws)
#define Wt_in ((bf16*)(ws + WS_WIN))
#define Wt_out ((bf16*)(ws + WS_WOUT))
#define Wt_up ((bf16*)(ws + WS_WUP))
#define Wt_dn ((bf16*)(ws + WS_WDN))
#define rope ((float*)(ws + WS_ROPE))
#define Hb ((bf16*)(ws + WS_H))
#define Pb ((bf16*)(ws + WS_P))
#define Qb ((bf16*)(ws + WS_Q))
#define Kb ((bf16*)(ws + WS_K))
#define Vb ((bf16*)(ws + WS_V))
#define Yb ((bf16*)(ws + WS_Y))
#define ACTb ((bf16*)(ws + WS_ACT))
#define Zb ((bf16*)(ws + WS_Z))
#define SSQ ((float*)(ws + WS_SSQ))
#define RS1 ((float*)(ws + WS_RS1))
#define RS2 ((float*)(ws + WS_RS2))
#define MIXb ((bf16*)(ws + WS_X1))
#define X1b ((bf16*)(ws + WS_X1))

    for (int u = tid; u < (LDS_BYTES - LDSCTL_OFF) / 4; u += NTHR) ((LAS unsigned*)(L + LDSCTL_OFF))[u] = 0u;
    __syncthreads();
#if !USE_CG_SYNC
    XcdBarrier bar = xcd_barrier_post((unsigned*)(ws + WS_CTL) + CW_BAR, (volatile LAS unsigned*)(L + MISC_OFF) + 8);
#define GRID_BAR() xcd_barrier(bar)
#else
#define GRID_BAR() grid.sync()
#endif
#define GRID_BAR_CG() grid.sync()

#ifndef SKIP_P0
    {
        int tid0 = threadIdx.x; asm volatile("" : "+v"(tid0)); const int tid = tid0, lane = tid0 & 63;
        LAS float* scr = (LAS float*)(L + wave * 16384);
        constexpr int I_IN = (DM / 64) * (NIN / 32), I_OUT = (DM / 64) * (DM / 32), I_UP = (DM / 64) * (NUP / 32), I_DN = (DFF / 64) * (DM / 32);
        constexpr int NITEMS = I_IN + I_OUT + I_UP + I_DN;
        for (int it = gw; it < NITEMS; it += NGW) {
            int r = it;
            if (r < I_IN) { p0_transpose_item(w_in, DM, NIN, Wt_in, scr, r, lane, g_mix_pre, g_mix_pre, DM); continue; } r -= I_IN;
            if (r < I_OUT) { p0_transpose_item(w_out, DM, DM, Wt_out, scr, r, lane, g_pool_out, g_attn_out, PW); continue; } r -= I_OUT;
            if (r < I_UP) { p0_transpose_item(w_up, DM, NUP, Wt_up, scr, r, lane, g_ffn_pre, g_ffn_pre, DM, true); continue; } r -= I_UP;
            p0_transpose_item(w_down, DFF, DM, Wt_dn, scr, r, lane);
        }
        for (int idx = bx * NTHR + tid; idx < SS * 8; idx += G * NTHR) {
            const int t = idx >> 3, i = idx & 7;
            double x = (double)t * ROPE_REV[i]; x -= __builtin_rint(x);
            const float xf = (float)x;
            rope[t * 16 + i] = __builtin_amdgcn_cosf(xf); rope[t * 16 + 8 + i] = __builtin_amdgcn_sinf(xf);
        }
        for (int mb = gw; mb < M; mb += 4 * NGW) {
            f32x4 v[4][4];
#pragma unroll
            for (int k = 0; k < 4; ++k) { const f32x4* xr = (const f32x4*)xrow_ptr(xp, xs, mb + k * NGW) + lane;
#pragma unroll
                for (int j = 0; j < 4; ++j) v[k][j] = __builtin_nontemporal_load(xr + 64 * j); }
#pragma unroll
            for (int k = 0; k < 4; ++k) { const int m = mb + k * NGW; float sq = 0.f;
#pragma unroll
                for (int j = 0; j < 4; ++j) sq += (v[k][j].x * v[k][j].x + v[k][j].y * v[k][j].y) + (v[k][j].z * v[k][j].z + v[k][j].w * v[k][j].w);
                const float r = 1.f / sqrtf(wave_sum(sq) * (1.f / DM) + EPS);
                if (lane == 0) RS1[m] = r;
                unsigned long long* o8 = (unsigned long long*)(Hb + (size_t)m * DM) + lane;
#pragma unroll
                for (int j = 0; j < 4; ++j) o8[64 * j] = (unsigned long long)pk2(v[k][j].x, v[k][j].y) | ((unsigned long long)pk2(v[k][j].z, v[k][j].w) << 32); }
        }
    }
#endif
    GRID_BAR();
    if (gridDim.x > 65535u) GRID_BAR_CG();

#ifndef SKIP_P1
    {
        pg8::Gemm g{Hb, Wt_in, M, NIN, DM}; pg8::StaticOrder S; S.init(M, NIN, G, bx);
        pg8::EpiProj E{Pb, Qb, rope, RS1};
        pg8::gemm_phase<pg8::EpiProj, pg8::StaticOrder, true, true>(L, g, S, E);
    }
#endif
    GRID_BAR();

#ifndef SKIP_P2A
    {
        int tida = threadIdx.x; asm volatile("" : "+v"(tida));
        const int lane_a = tida & 63, fr = lane_a & 15, fq = lane_a >> 4, vrow = lane_a >> 3, vch = lane_a & 7;
        LAS unsigned char* OACC = L;
        LAS float* MLA = (LAS float*)(L + 65536);
        LAS unsigned char* VST = L + 67584 + wave * 8192;
        constexpr int NUNIT = NH * (M / 256);
        const int nu = vcu < NUNIT ? (NUNIT - vcu + G - 1) / G : 0, nj = nu * 6;
        typedef short s16x4 __attribute__((ext_vector_type(4)));
        typedef short v4i16_t __attribute__((ext_vector_type(4)));
#define ATT_PARAMS(J, h_, m0_, S_, B_, Bo_, d_, p_, off_) do { const int ui_ = (J) / 6, jb_ = (J) - 6 * ui_; const int unit_ = ui_ * G + vcu; h_ = unit_ / (M / 256); m0_ = (unit_ % (M / 256)) * 256; \
            int s0_; seq_of(m0_, s0_, S_); p_ = jb_ >> 1; const int tau_ = wave + 8 * (jb_ & 1); d_ = p_ == 0 ? 1 : (p_ == 1 ? 4 : 16); \
            Bo_ = p_ == 0 ? 16 * tau_ : (p_ == 1 ? 64 * (tau_ >> 2) + (tau_ & 3) : tau_); B_ = (m0_ - s0_) + Bo_; off_ = ((size_t)h_ * M + s0_) * 64; } while (0)
        const unsigned vsw = 16u * (unsigned)(vch ^ (((vrow >> 1) & 3) << 1));
#define ATT_ISSUE(g_, i_, B_, d_, S_, off_) do { \
            _Pragma("unroll") for (int j = 0; j < 2; ++j) { const int r_ = 8 * j + vrow; const char* src_; \
                if ((i_) == 0) { src_ = (const char*)(Qb + (off_)) + ((unsigned)((B_) + (d_) * r_) * 128u + 16u * (unsigned)(vch ^ ((4 * j + (vrow >> 1)) & 7))); } \
                else if ((i_) < 10) { const unsigned tk = (unsigned)min(max((B_) + (d_) * (16 * ((i_) - 1) + r_ - 64), 0), (S_) - 1); src_ = (const char*)(Kb + (off_)) + (tk * 128u + 16u * (unsigned)(vch ^ ((4 * j + (vrow >> 1)) & 7))); } \
                else { const unsigned tk = (unsigned)min(max((B_) + (d_) * (16 * ((i_) - 10) + r_ - 64), 0), (S_) - 1); src_ = (const char*)(Vb + (off_)) + (tk * 128u + vsw); } \
                __builtin_amdgcn_global_load_lds((const unsigned*)src_, (LAS unsigned*)(VST + ((((g_)) & 3) << 11) + j * 1024), 16, 0, 0); } } while (0)
#define ATT_AHEAD(i_) do { asm volatile("s_waitcnt lgkmcnt(0)" ::: "memory"); if ((i_) < 19) ATT_ISSUE(gb + (i_), (i_), B, d, S, off); else ATT_ISSUE(gb + (i_), (i_) - 19, Bn, dn, Sn, offn); } while (0)
#define ATT_READY() asm volatile("s_waitcnt vmcnt(6)" ::: "memory")
        pg8::bf16x8 qf[2];
        int h = 0, m0 = 0, S = 1, B = 0, Bo = 0, d = 1, p = 0; size_t off = 0;
        if (nj > 0) { ATT_PARAMS(0, h, m0, S, B, Bo, d, p, off); ATT_ISSUE(0, 0, B, d, S, off); ATT_ISSUE(1, 1, B, d, S, off); ATT_ISSUE(2, 2, B, d, S, off); }
#pragma unroll 1
        for (int J = 0; J < nj; ++J) {
            int hn, m0n, Sn, Bn, Bon, dn, pn; size_t offn; { const int Jn = J + 1 < nj ? J + 1 : J; ATT_PARAMS(Jn, hn, m0n, Sn, Bn, Bon, dn, pn, offn); }
            const int gb = 19 * J;
            f32x4 sc[9];
            { ATT_AHEAD(3); ATT_READY(); const LAS unsigned char* sl = VST + ((gb & 3) << 11); const int ks_ = (fr >> 1) & 7;
              qf[0] = *(const LAS pg8::bf16x8*)(sl + fr * 128 + 16 * (fq ^ ks_)); qf[1] = *(const LAS pg8::bf16x8*)(sl + fr * 128 + 16 * ((fq + 4) ^ ks_)); }
#pragma unroll
            for (int kb = 0; kb < 9; ++kb) { ATT_AHEAD(kb + 4); ATT_READY();
                const LAS unsigned char* sl = VST + (((gb + 1 + kb) & 3) << 11); const int ks_ = (fr >> 1) & 7;
                const pg8::bf16x8 k0 = *(const LAS pg8::bf16x8*)(sl + fr * 128 + 16 * (fq ^ ks_)), k1 = *(const LAS pg8::bf16x8*)(sl + fr * 128 + 16 * ((fq + 4) ^ ks_));
                f32x4 c = (f32x4){0.f, 0.f, 0.f, 0.f};
                c = __builtin_amdgcn_mfma_f32_16x16x32_bf16(k0, qf[0], c, 0, 0, 0);
                c = __builtin_amdgcn_mfma_f32_16x16x32_bf16(k1, qf[1], c, 0, 0, 0); sc[kb] = c; }
#pragma unroll
            for (int r = 0; r < 4; ++r) { if (4 * fq + r < fr) sc[0][r] = -INFINITY; if (4 * fq + r > fr) sc[8][r] = -INFINITY; }
            if (B - 64 * d < 0 || B + 79 * d >= S) {
                const int klo = 64 - (B >> (2 * p)), khi = 64 + ((S - 1 - B) >> (2 * p));
                const int lo_l = klo - 4 * fq, hi_l = khi - 4 * fq;
#pragma unroll
                for (int kb = 0; kb < 9; ++kb)
#pragma unroll
                    for (int r = 0; r < 4; ++r) { if (16 * kb + r < lo_l || 16 * kb + r > hi_l) sc[kb][r] = -INFINITY; }
            }
            float mx = __builtin_fmaxf(__builtin_fmaxf(sc[0][0], sc[0][1]), __builtin_fmaxf(sc[0][2], sc[0][3]));
#pragma unroll
            for (int kb = 1; kb < 9; ++kb) { mx = __builtin_fmaxf(__builtin_fmaxf(mx, sc[kb][0]), sc[kb][1]); mx = __builtin_fmaxf(__builtin_fmaxf(mx, sc[kb][2]), sc[kb][3]); }
            mx = rows_max(mx);
            float ls = 0.f;
            s16x4 pf[9];
#pragma unroll
            for (int kb = 0; kb < 9; ++kb) { f32x4 e;
#pragma unroll
                for (int r = 0; r < 4; ++r) { e[r] = __builtin_amdgcn_exp2f(sc[kb][r] - mx); ls += e[r]; }
                v2u w; w.x = pg8::cvt_pk_bf16(e[0], e[1]); w.y = pg8::cvt_pk_bf16(e[2], e[3]); pf[kb] = __builtin_bit_cast(s16x4, w); }
            ls = rows_sum(ls);
            f32x4 o[4];
#pragma unroll
            for (int nb = 0; nb < 4; ++nb) o[nb] = (f32x4){0.f, 0.f, 0.f, 0.f};
#pragma unroll
            for (int kb = 0; kb < 9; ++kb) { ATT_AHEAD(kb + 13); ATT_READY();
                const LAS unsigned char* sl = VST + (((gb + 10 + kb) & 3) << 11);
                const int R = 4 * fq + (fr >> 2), pp = fr & 3;
                s16x4 vt[4];
#pragma unroll
                for (int nb = 0; nb < 4; ++nb) { const unsigned a_ = (unsigned)(size_t)(sl + R * 128 + 16 * ((2 * nb + (pp >> 1)) ^ (((R >> 1) & 3) << 1)) + 8 * (pp & 1));
                    asm volatile("ds_read_b64_tr_b16 %0, %1" : "=v"(vt[nb]) : "v"(a_) : "memory"); }
                asm volatile("s_waitcnt lgkmcnt(0)" ::: "memory"); __builtin_amdgcn_sched_barrier(0);
#pragma unroll
                for (int nb = 0; nb < 4; ++nb) o[nb] = __builtin_amdgcn_mfma_f32_16x16x16bf16_1k(vt[nb], pf[kb], o[nb], 0, 0, 0);
            }
            const int u = Bo + d * fr, sw = (u ^ (u >> 4)) & 15;
            if (p > 0) {
                const float ma = MLA[2 * u], la = MLA[2 * u + 1];
                const float mn = fmaxf(ma, mx), fa = __builtin_amdgcn_exp2f(ma - mn), fb = __builtin_amdgcn_exp2f(mx - mn);
                ls = la * fa + ls * fb; mx = mn;
#pragma unroll
                for (int nb = 0; nb < 4; ++nb) { const f32x4 oa = *(LAS f32x4*)(OACC + u * 256 + 16 * ((4 * nb + fq) ^ sw)); o[nb] = oa * fa + o[nb] * fb; }
            }
            if (p < 2) {
                if (fq == 0) { MLA[2 * u] = mx; MLA[2 * u + 1] = ls; }
#pragma unroll
                for (int nb = 0; nb < 4; ++nb) *(LAS f32x4*)(OACC + u * 256 + 16 * ((4 * nb + fq) ^ sw)) = o[nb];
            } else {
                const float inv = 1.f / ls;
                bf16* op = MIXb + (size_t)(m0 + u) * DM + PW + h * 64 + 4 * fq;
                float sq = 0.f;
#pragma unroll
                for (int nb = 0; nb < 4; ++nb) { const f32x4 ov = o[nb] * inv; sq += (ov[0] * ov[0] + ov[1] * ov[1]) + (ov[2] * ov[2] + ov[3] * ov[3]);
                    v2u w; w.x = pg8::cvt_pk_bf16(ov[0], ov[1]); w.y = pg8::cvt_pk_bf16(ov[2], ov[3]); *(v2u*)(op + 16 * nb) = w; }
                sq = rows_sum(sq);
                if (fq == 0) SSQ[(size_t)(m0 + u) * NH + h] = sq;
            }
            if ((J & 1) == 1) { asm volatile("s_waitcnt lgkmcnt(0)" ::: "memory"); __builtin_amdgcn_s_barrier(); asm volatile("" ::: "memory"); }
            h = hn; m0 = m0n; S = Sn; B = Bn; Bo = Bon; d = dn; p = pn; off = offn;
        }
        asm volatile("s_waitcnt vmcnt(0)" ::: "memory"); __syncthreads();
#undef ATT_PARAMS
#undef ATT_ISSUE
#undef ATT_AHEAD
#undef ATT_READY
    }
#endif
#ifndef SKIP_P2B
    {
        int tidp = threadIdx.x; asm volatile("" : "+v"(tidp));
        const int lp = tidp & 63, fr = lp & 15, fq = lp >> 4;
        constexpr int PPITCH = 528;
        LAS unsigned char* PST = L;
        LAS unsigned char* POOL = L + 80 * PPITCH;
        LAS float* SSP = (LAS float*)(L + 144 * PPITCH);
        const int g = wave & 3, th = wave >> 2;
        pg8::bf16x8 wf[4][2];
#pragma unroll
        for (int eb = 0; eb < 4; ++eb)
#pragma unroll
            for (int ks = 0; ks < 2; ++ks) { const float* wp = pool_w + ((size_t)(g * 64 + 32 * ks + 8 * fq) * 64 + 16 * eb + fr);
                v4u w; w.x = pk2(wp[0], wp[64]); w.y = pk2(wp[128], wp[192]); w.z = pk2(wp[256], wp[320]); w.w = pk2(wp[384], wp[448]); wf[eb][ks] = __builtin_bit_cast(pg8::bf16x8, w); }
        for (int item = bx; item < M / 64; item += G) {
            const int m0 = item * 64;
            int s0, S; seq_of(m0, s0, S);
            const int t0 = m0 - s0;
            for (int q = tidp; q < 80 * 32; q += NTHR) { const int row = q >> 5, ch = q & 31; const int t = t0 - 8 + row;
                if (t >= 0 && t < S) *(LAS v4u*)(PST + row * PPITCH + 16 * ch) = *(const v4u*)(Pb + (size_t)(s0 + t) * PW + 8 * ch); }
            __syncthreads();
            { const int tok = tidp >> 3, part = tidp & 7, gg = part >> 1, hw = 1 << gg; const int t = t0 + tok;
              const int lo = (t - hw) > 0 ? (t - hw) : 0, hi = (t + hw) < S ? (t + hw) : S;
              float sum[32];
#pragma unroll
              for (int i = 0; i < 32; ++i) sum[i] = 0.f;
              for (int tr = lo; tr < hi; ++tr) { const LAS v4u* rp = (const LAS v4u*)(PST + (tr - t0 + 8) * PPITCH + 64 * part);
#pragma unroll
                  for (int c = 0; c < 4; ++c) { const v4u w = rp[c]; sum[8 * c + 0] += bflo(w.x); sum[8 * c + 1] += bfhi(w.x); sum[8 * c + 2] += bflo(w.y); sum[8 * c + 3] += bfhi(w.y);
                      sum[8 * c + 4] += bflo(w.z); sum[8 * c + 5] += bfhi(w.z); sum[8 * c + 6] += bflo(w.w); sum[8 * c + 7] += bfhi(w.w); } }
              const float rc = 1.f / (float)(hi - lo);
              const LAS v4u* cp = (const LAS v4u*)(PST + (tok + 8) * PPITCH + 64 * part);
#pragma unroll
              for (int c = 0; c < 4; ++c) { const v4u w = cp[c]; v4u o;
                  o.x = pk2(sum[8 * c + 0] * rc - bflo(w.x), sum[8 * c + 1] * rc - bfhi(w.x)); o.y = pk2(sum[8 * c + 2] * rc - bflo(w.y), sum[8 * c + 3] * rc - bfhi(w.y));
                  o.z = pk2(sum[8 * c + 4] * rc - bflo(w.z), sum[8 * c + 5] * rc - bfhi(w.z)); o.w = pk2(sum[8 * c + 6] * rc - bflo(w.w), sum[8 * c + 7] * rc - bfhi(w.w));
                  *(LAS v4u*)(POOL + tok * PPITCH + 64 * part + 16 * c) = o; } }
            __syncthreads();
            f32x4 acc[2][4];
#pragma unroll
            for (int tb = 0; tb < 2; ++tb) {
                const LAS unsigned char* prow = POOL + (32 * th + 16 * tb + fr) * PPITCH + 128 * g + 16 * fq;
                const pg8::bf16x8 b0 = *(const LAS pg8::bf16x8*)(prow), b1 = *(const LAS pg8::bf16x8*)(prow + 64);
#pragma unroll
                for (int eb = 0; eb < 4; ++eb) { f32x4 c = (f32x4){0.f, 0.f, 0.f, 0.f};
                    c = __builtin_amdgcn_mfma_f32_16x16x32_bf16(wf[eb][0], b0, c, 0, 0, 0); c = __builtin_amdgcn_mfma_f32_16x16x32_bf16(wf[eb][1], b1, c, 0, 0, 0);
                    const f32x4 sv = *(const f32x4*)(pool_scale + g * 64 + 16 * eb + 4 * fq); acc[tb][eb] = c * sv; }
                float sq = 0.f;
#pragma unroll
                for (int eb = 0; eb < 4; ++eb) sq += (acc[tb][eb][0] * acc[tb][eb][0] + acc[tb][eb][1] * acc[tb][eb][1]) + (acc[tb][eb][2] * acc[tb][eb][2] + acc[tb][eb][3] * acc[tb][eb][3]);
                sq += __shfl_xor(sq, 16); sq += __shfl_xor(sq, 32);
                if (fq == 0) SSP[(32 * th + 16 * tb + fr) * 4 + g] = sq;
            }
            __syncthreads();
#pragma unroll
            for (int tb = 0; tb < 2; ++tb) { const int tok = 32 * th + 16 * tb + fr; const f32x4 pp = *(const LAS f32x4*)(SSP + tok * 4);
                const float r = 1.f / sqrtf(((pp[0] + pp[1]) + (pp[2] + pp[3])) * (1.f / PW) + EPS);
                bf16* op = MIXb + (size_t)(m0 + tok) * DM + g * 64 + 4 * fq;
#pragma unroll
                for (int eb = 0; eb < 4; ++eb) { const f32x4 v = acc[tb][eb] * r; v2u w; w.x = pg8::cvt_pk_bf16(v[0], v[1]); w.y = pg8::cvt_pk_bf16(v[2], v[3]); *(v2u*)(op + 16 * eb) = w; } }
        }
        __syncthreads();
    }
#endif
    GRID_BAR();

#ifndef SKIP_P3
    {
        pg8::Gemm g{MIXb, Wt_out, M, DM, DM}; pg8::StaticOrder S; S.init(M, DM, G, bx);
        pg8::EpiOutProj E{Yb, DM, SSQ};
        pg8::gemm_phase<pg8::EpiOutProj, pg8::StaticOrder, true, true>(L, g, S, E);
    }
#endif
    GRID_BAR();

#ifndef SKIP_P4
    { int tid4 = threadIdx.x; asm volatile("" : "+v"(tid4)); const int lane = tid4 & 63;
    for (int mb = gw; mb < M; mb += 4 * NGW) {
        f32x4 y[4][4], x[4][4];
#pragma unroll
        for (int k = 0; k < 4; ++k) { const int m = mb + k * NGW; const v2u* xr = (const v2u*)(Hb + (size_t)m * DM) + lane; const v2u* yr = (const v2u*)(Yb + (size_t)m * DM) + lane;
#pragma unroll
            for (int j = 0; j < 4; ++j) { const v2u w = __builtin_nontemporal_load(yr + 64 * j); y[k][j] = (f32x4){bflo(w.x), bfhi(w.x), bflo(w.y), bfhi(w.y)}; const v2u xw = __builtin_nontemporal_load(xr + 64 * j); x[k][j] = (f32x4){bflo(xw.x), bfhi(xw.x), bflo(xw.y), bfhi(xw.y)}; } }
#pragma unroll
        for (int k = 0; k < 4; ++k) { const int m = mb + k * NGW; float s = 0.f;
#pragma unroll
            for (int j = 0; j < 4; ++j) s += (y[k][j].x * y[k][j].x + y[k][j].y * y[k][j].y) + (y[k][j].z * y[k][j].z + y[k][j].w * y[k][j].w);
            const float r = 1.f / sqrtf(wave_sum(s) * (1.f / DM) + EPS);
            float s2 = 0.f;
            unsigned long long* x1row = (unsigned long long*)(X1b + (size_t)m * DM) + lane;
#pragma unroll
            for (int j = 0; j < 4; ++j) { const f32x4 gv = ((const f32x4*)g_mix_post)[64 * j + lane]; x[k][j] = x[k][j] + y[k][j] * r * gv;
                x1row[64 * j] = (unsigned long long)pk2(x[k][j].x, x[k][j].y) | ((unsigned long long)pk2(x[k][j].z, x[k][j].w) << 32);
                s2 += (x[k][j].x * x[k][j].x + x[k][j].y * x[k][j].y) + (x[k][j].z * x[k][j].z + x[k][j].w * x[k][j].w); }
            const float r2 = 1.f / sqrtf(wave_sum(s2) * (1.f / DM) + EPS);
            if (lane == 0) RS2[m] = r2; }
    } }
#endif
    GRID_BAR();

#ifndef SKIP_P567
    {
        pg8::Gemm g{X1b, Wt_up, pg8::EpiConvGelu::NTILES * 256, NUP, DM}; pg8::StaticOrder S; S.init(pg8::EpiConvGelu::NTILES * 256, NUP, G, bx);
        pg8::EpiConvGelu E{ACTb, conv_w, conv_b, RS2};
        pg8::gemm_phase<pg8::EpiConvGelu, pg8::StaticOrder, true, true>(L, g, S, E);
    }
    GRID_BAR();
    {
        pg8::Gemm g{ACTb, Wt_dn, M, DM, DFF}; pg8::StaticOrder S; S.init(M, DM, G, bx);
        pg8::EpiStore E{Zb, DM};
        pg8::gemm_phase<pg8::EpiStore, pg8::StaticOrder, true, true>(L, g, S, E);
    }
    GRID_BAR();
#endif
#ifndef SKIP_P8
    { int tid8 = threadIdx.x; asm volatile("" : "+v"(tid8)); const int lane = tid8 & 63;
    for (int mb = gw; mb < M; mb += 4 * NGW) {
        f32x4 z[4][4], x1[4][4];
#pragma unroll
        for (int k = 0; k < 4; ++k) { const int m = mb + k * NGW; const v2u* zr = (const v2u*)(Zb + (size_t)m * DM) + lane; const v2u* x1r = (const v2u*)(X1b + (size_t)m * DM) + lane;
#pragma unroll
            for (int j = 0; j < 4; ++j) { const v2u w = __builtin_nontemporal_load(zr + 64 * j); z[k][j] = (f32x4){bflo(w.x), bfhi(w.x), bflo(w.y), bfhi(w.y)}; const v2u xw = __builtin_nontemporal_load(x1r + 64 * j); x1[k][j] = (f32x4){bflo(xw.x), bfhi(xw.x), bflo(xw.y), bfhi(xw.y)}; } }
#pragma unroll
        for (int k = 0; k < 4; ++k) { const int m = mb + k * NGW; float s = 0.f;
#pragma unroll
            for (int j = 0; j < 4; ++j) s += (z[k][j].x * z[k][j].x + z[k][j].y * z[k][j].y) + (z[k][j].z * z[k][j].z + z[k][j].w * z[k][j].w);
            const float r = 1.f / sqrtf(wave_sum(s) * (1.f / DM) + EPS);
            f32x4* orow = (f32x4*)(out + (size_t)m * DM) + lane;
#pragma unroll
            for (int j = 0; j < 4; ++j) { const f32x4 gv = ((const f32x4*)g_ffn_post)[64 * j + lane]; __builtin_nontemporal_store(x1[k][j] + z[k][j] * r * gv, orow + 64 * j); } }
    } }
#endif
}

#undef out
#undef ws
#undef rope
extern "C" void kernel_launch(void* const* d_in, const int* in_sizes, int n_in, void* d_out, int out_size, void* d_ws, size_t ws_size, hipStream_t stream) {
    static int grid = 0;
    if (grid == 0) {
        if (n_in != 16 || out_size != M * DM || ws_size < WS_END) { fprintf(stderr, "kernel_launch: unexpected shapes (n_in %d out %d ws %zu)\n", n_in, out_size, ws_size); grid = -1; return; }
        int dev = 0, cus = 0, per_cu = 0;
        hipGetDevice(&dev); hipDeviceGetAttribute(&cus, hipDeviceAttributeMultiprocessorCount, dev);
        hipFuncSetAttribute((const void*)hymba_fwd, hipFuncAttributeMaxDynamicSharedMemorySize, LDS_BYTES);
        hipOccupancyMaxActiveBlocksPerMultiprocessor(&per_cu, (const void*)hymba_fwd, NTHR, LDS_BYTES);
        (void)hipGetLastError();
        if (per_cu < 1) per_cu = 1;
        grid = cus;
    }
    if (grid < 0) return;
    hipMemsetAsync((char*)d_ws + WS_CTL, 0, CTL_ZERO_BYTES, stream);
    Args a{};
    for (int i = 0; i < 16; ++i) a.in[i] = (const float*)d_in[i];
    a.out = (float*)d_out; a.ws = (unsigned char*)d_ws;
    void* kargs[] = {&a};
    hipError_t e = hipLaunchCooperativeKernel((const void*)hymba_fwd, dim3(grid), dim3(NTHR), kargs, LDS_BYTES, stream);
    if (e != hipSuccess) fprintf(stderr, "cooperative launch failed: %s (grid %d)\n", hipGetErrorString(e), grid);
}
```

```cpp
#include <hip/hip_runtime.h>
#include <hip/hip_cooperative_groups.h>
#include <cstdio>
#include <cstdint>
namespace cg = cooperative_groups;

#ifndef USE_CG_SYNC
#define USE_CG_SYNC 0
#endif

namespace pg8 {
#define PG8_LAS __attribute__((address_space(3)))
typedef unsigned short bf16_t;
typedef short bf16x8 __attribute__((ext_vector_type(8)));
typedef float f32x4 __attribute__((ext_vector_type(4)));
typedef unsigned u32x4 __attribute__((ext_vector_type(4)));
constexpr int BM = 256, BK = 64, HALF = 128, HTB = HALF * BK * 2, STAGE_BYTES = 8 * HTB, NXCD = 8, WGM = 8;

__host__ __device__ __forceinline__ int lds_byte(int r, int c) { const int st = (r >> 4) * 2 + (c >> 5), rr = r & 15, cc = c & 31, ob = rr * 64 + cc * 2; return st * 1024 + (ob ^ (((ob >> 9) & 1) << 5)); }
__host__ __device__ __forceinline__ void stage_rc(int b, int& R, int& C) { const int st = b / 1024, sb = b % 1024, swz = sb ^ (((sb >> 9) & 1) << 5); R = (st >> 1) * 16 + swz / 64; C = (st & 1) * 32 + (swz % 64) / 2; }
__host__ __device__ __forceinline__ int perm32(int rho) { const int n = rho >> 4, i = rho & 15; return 8 * (i >> 2) + 4 * n + (i & 3); }

constexpr int MTOK = 49152, NTOKP = 16384;
constexpr float C2 = 0.125f * 1.4426950408889634f;
struct Unit { int pm, pn; };
struct Gemm { const bf16_t* A; const bf16_t* Bt; int M, N, K; };

struct StaticOrder {
    int nM, nN, nwg, G, c;
    __host__ __device__ void init(int M, int N, int G_, int c_) { nM = M / BM; nN = N / BM; nwg = nM * nN; G = G_; c = c_; }
    __host__ __device__ bool next(int i, Unit& u) const {
        const long L = (long)i * G + c; if (L >= nwg) return false;
        int wgid = (int)L; { const int q = nwg / NXCD, r = nwg % NXCD, xcd = wgid % NXCD, off = wgid / NXCD; wgid = (xcd < r ? xcd * (q + 1) : r * (q + 1) + (xcd - r) * q) + off; }
        const int nig = WGM * nN, gid = wgid / nig, fm = gid * WGM, gsz = (nM - fm) < WGM ? (nM - fm) : WGM;
        u.pm = fm + ((wgid % nig) % gsz); u.pn = (wgid % nig) / gsz; return true;
    }
    __device__ __forceinline__ void a_ready(const Unit&) const {}
    __device__ __forceinline__ void done(const Unit&) const {}
};

__device__ __forceinline__ unsigned cvt_pk_bf16(float lo, float hi) { unsigned r; asm volatile("v_cvt_pk_bf16_f32 %0, %1, %2" : "=v"(r) : "v"(lo), "v"(hi)); return r; }
typedef float f32x2 __attribute__((ext_vector_type(2)));
__device__ __forceinline__ f32x2 gelu_pk(f32x2 v) {
    const f32x2 av = __builtin_elementwise_abs(v), d = av * 0.2316418882f + 1.0f;
    f32x2 t; t.x = __builtin_amdgcn_rcpf(d.x); t.y = __builtin_amdgcn_rcpf(d.y);
    f32x2 q = t * 0.5307027145f + (-0.7265760135f); q = q * t + 0.7107068705f; q = q * t + (-0.142248368f); q = q * t + 0.127414796f; q = q * t;
    const f32x2 s = (v * v) * (-0.72134752044f);
    f32x2 e; e.x = __builtin_amdgcn_exp2f(s.x); e.y = __builtin_amdgcn_exp2f(s.y);
    const f32x2 m = v * (q * e), r = v - m;
    f32x2 o; o.x = v.x < 0.f ? m.x : r.x; o.y = v.y < 0.f ? m.y : r.y; return o;
}

struct EpiStore {
    static constexpr bool PERM = true, AFTER_DRAIN = false; static constexpr bool NEEDS_LDS = false; static __device__ __forceinline__ int row0(int pm) { return pm * BM; } static constexpr int MIDK_T = 0;
    bf16_t* O; int ldc;
    __device__ __forceinline__ void operator()(const f32x4 (&acc)[2][2][4][2], const Unit& u, int wr, int wc, int fr, int fq) const {
        const int lane = fq * 16 + fr, srcl = 16 * (lane & 3) + (lane >> 2), r2 = lane >> 2, c2 = lane & 3;
        const int row0 = u.pm * BM + wr * 64 + r2; const int col0 = u.pn * BM + wc * 32 + 8 * c2;
#pragma unroll
        for (int ai = 0; ai < 2; ++ai)
#pragma unroll
            for (int m = 0; m < 4; ++m) { bf16_t* rowp = O + (size_t)(row0 + ai * HALF + m * 16) * ldc + col0;
#pragma unroll
                for (int bj = 0; bj < 2; ++bj) { const f32x4 v0 = acc[ai][bj][m][0], v1 = acc[ai][bj][m][1];
                    u32x4 w; w.x = __shfl(cvt_pk_bf16(v0[0], v0[1]), srcl); w.y = __shfl(cvt_pk_bf16(v0[2], v0[3]), srcl); w.z = __shfl(cvt_pk_bf16(v1[0], v1[1]), srcl); w.w = __shfl(cvt_pk_bf16(v1[2], v1[3]), srcl);
                    *(u32x4*)(rowp + bj * HALF) = w; } }
    }
};

struct EpiOutProj {
    static constexpr bool PERM = true, AFTER_DRAIN = false; static constexpr bool NEEDS_LDS = false; static __device__ __forceinline__ int row0(int pm) { return pm * BM; } static constexpr int MIDK_T = 4;
    bf16_t* O; int ldc; const float* ssq;
    __device__ __forceinline__ float sattn(int row) const { const f32x4* p = (const f32x4*)(ssq + (size_t)row * 12); const f32x4 a = p[0], b = p[1], c = p[2];
        return sqrtf((((a[0] + a[1]) + (a[2] + a[3])) + ((b[0] + b[1]) + (b[2] + b[3])) + ((c[0] + c[1]) + (c[2] + c[3]))) * (1.f / 768.f) + 1e-6f); }
    __device__ __forceinline__ void midk(f32x4 (&acc)[2][2][4][2], const Unit& u, int wr, int) const {
        int tl = threadIdx.x; asm volatile("" : "+v"(tl));
        const int row0 = u.pm * BM + wr * 64 + (tl & 15);
#pragma unroll
        for (int ai = 0; ai < 2; ++ai)
#pragma unroll
            for (int m = 0; m < 4; ++m) { const float sv = sattn(row0 + ai * HALF + m * 16);
#pragma unroll
                for (int bj = 0; bj < 2; ++bj)
#pragma unroll
                    for (int n = 0; n < 2; ++n) acc[ai][bj][m][n] = acc[ai][bj][m][n] * sv; }
    }
    __device__ __forceinline__ void operator()(const f32x4 (&acc)[2][2][4][2], const Unit& u, int wr, int wc, int fr, int fq) const {
        const int row0 = u.pm * BM + wr * 64 + fr; const int col0 = u.pn * BM + wc * 32 + 8 * fq;
#pragma unroll
        for (int ai = 0; ai < 2; ++ai)
#pragma unroll
            for (int m = 0; m < 4; ++m) { const int row = row0 + ai * HALF + m * 16; const float r = 1.f / sattn(row); bf16_t* rowp = O + (size_t)row * ldc + col0;
#pragma unroll
                for (int bj = 0; bj < 2; ++bj) { const f32x4 v0 = acc[ai][bj][m][0] * r, v1 = acc[ai][bj][m][1] * r;
                    u32x4 w; w.x = cvt_pk_bf16(v0[0], v0[1]); w.y = cvt_pk_bf16(v0[2], v0[3]); w.z = cvt_pk_bf16(v1[0], v1[1]); w.w = cvt_pk_bf16(v1[2], v1[3]);
                    *(u32x4*)(rowp + bj * HALF) = w; } }
    }
};

struct EpiConvGelu {
    static constexpr bool PERM = true, AFTER_DRAIN = false, NEEDS_LDS = true; static constexpr int MIDK_T = 0;
    static constexpr int NTILES = (MTOK + 253) / 254;
    bf16_t* ACT; const float* cw; const float* cb; const float* rs;
    static __device__ __forceinline__ int row0(int pm) { return 254 * pm - 1; }
    __device__ __forceinline__ void run(f32x4 (&acc)[2][2][4][2], const Unit& u, int wr, int wc, PG8_LAS unsigned char* xbuf) const {
        int tl = threadIdx.x; asm volatile("" : "+v"(tl));
        const int lane = tl & 63, fr = lane & 15, fq = lane >> 4;
        const int rb = 254 * u.pm - 1;
        const int colw = 32 * wc + 8 * fq, ch0 = 128 * u.pn + colw;
        PG8_LAS float* X = (PG8_LAS float*)xbuf;
#pragma unroll
        for (int ai = 0; ai < 2; ++ai)
#pragma unroll
            for (int m = 0; m < 4; ++m) { int row = rb + 128 * ai + 64 * wr + 16 * m + fr; row = row < 0 ? 0 : (row > MTOK - 1 ? MTOK - 1 : row); const float rr = rs[row];
#pragma unroll
                for (int bj = 0; bj < 2; ++bj)
#pragma unroll
                    for (int n = 0; n < 2; ++n) acc[ai][bj][m][n] = acc[ai][bj][m][n] * rr; }
#pragma unroll
        for (int ai = 0; ai < 2; ++ai) { const int c = 2 * ai + wr;
#pragma unroll
            for (int bj = 0; bj < 2; ++bj)
#pragma unroll
                for (int n = 0; n < 2; ++n) { const int col = 128 * bj + colw + 4 * n;
                    if (fr == 0) *(PG8_LAS f32x4*)(X + (c * 2 + 0) * 256 + col) = acc[ai][bj][0][n];
                    if (fr == 15) *(PG8_LAS f32x4*)(X + (c * 2 + 1) * 256 + col) = acc[ai][bj][3][n]; } }
        asm volatile("s_waitcnt lgkmcnt(0)" ::: "memory"); __builtin_amdgcn_s_barrier(); asm volatile("" ::: "memory");
        const int lo_ = rb, hi_ = rb + 255, lg_ = hi_ < NTOKP ? 11 : 14;
        const bool hasb = (lo_ < NTOKP && hi_ >= NTOKP) || (((hi_ + 1) >> lg_) >= ((lo_ + (1 << lg_) - 1) >> lg_));
        if (hasb) body<true>(acc, u, wr, wc, X, fr, fq, rb, colw, ch0); else body<false>(acc, u, wr, wc, X, fr, fq, rb, colw, ch0);
    }
    template <bool HASB>
    __device__ __forceinline__ void body(f32x4 (&acc)[2][2][4][2], const Unit& u, int wr, int wc, PG8_LAS float* X, int fr, int fq, int rb, int colw, int ch0) const {
        typedef unsigned u32x2 __attribute__((ext_vector_type(2)));
        u32x2 stash[2][4];
#pragma unroll
        for (int n = 0; n < 2; ++n) {
            f32x4 wg[3], wv[3];
#pragma unroll
            for (int t3 = 0; t3 < 3; ++t3) { wg[t3] = *(const f32x4*)(cw + (size_t)t3 * 5632 + ch0 + 4 * n); wv[t3] = *(const f32x4*)(cw + (size_t)t3 * 5632 + 2816 + ch0 + 4 * n); }
            const f32x4 bg = *(const f32x4*)(cb + ch0 + 4 * n), bv = *(const f32x4*)(cb + 2816 + ch0 + 4 * n);
#pragma unroll
            for (int ai = 0; ai < 2; ++ai) { const int c = 2 * ai + wr;
                f32x4 pr[2], nx[2];
#pragma unroll
                for (int bj = 0; bj < 2; ++bj) { const int col = 128 * bj + colw + 4 * n;
                    pr[bj] = *(const PG8_LAS f32x4*)(X + ((c > 0 ? c - 1 : 0) * 2 + 1) * 256 + col); nx[bj] = *(const PG8_LAS f32x4*)(X + ((c < 3 ? c + 1 : 3) * 2 + 0) * 256 + col); }
#pragma unroll
                for (int m = 0; m < 4; ++m) {
                    const int rt = 128 * ai + 64 * wr + 16 * m + fr, row = rb + rt;
                    const int Sm1 = row < NTOKP ? 2047 : 16383, t = row & Sm1;
                    const bool z_up = t == 0, z_dn = t == Sm1;
                    f32x4 y[2];
#pragma unroll
                    for (int bj = 0; bj < 2; ++bj) { const f32x4 x = acc[ai][bj][m][n];
                        const f32x4 srcu = m > 0 ? acc[ai][bj][m > 0 ? m - 1 : 0][n] : pr[bj], srcd = m < 3 ? acc[ai][bj][m < 3 ? m + 1 : 3][n] : nx[bj];
                        f32x4 up, dn;
#pragma unroll
                        for (int e = 0; e < 4; ++e) { const float su = fr == 15 ? srcu[e] : x[e], sd = fr == 0 ? srcd[e] : x[e];
                            const float gu = __builtin_bit_cast(float, __builtin_amdgcn_update_dpp(0, __builtin_bit_cast(int, su), 0x121, 0xF, 0xF, false));
                            const float gd = __builtin_bit_cast(float, __builtin_amdgcn_update_dpp(0, __builtin_bit_cast(int, sd), 0x12F, 0xF, 0xF, false));
                            up[e] = (HASB && z_up) ? 0.f : gu; dn[e] = (HASB && z_dn) ? 0.f : gd; }
                        y[bj] = bj ? (bv + wv[0] * up + wv[1] * x + wv[2] * dn) : (bg + wg[0] * up + wg[1] * x + wg[2] * dn); }
                    const f32x2 g0 = gelu_pk((f32x2){y[0][0], y[0][1]}), g1 = gelu_pk((f32x2){y[0][2], y[0][3]});
                    u32x2 w; w.x = cvt_pk_bf16(g0.x * y[1][0], g0.y * y[1][1]); w.y = cvt_pk_bf16(g1.x * y[1][2], g1.y * y[1][3]);
                    if (n == 0) stash[ai][m] = w;
                    else if (rt >= 1 && rt <= 254 && row < MTOK) { u32x4 w4; w4.x = stash[ai][m].x; w4.y = stash[ai][m].y; w4.z = w.x; w4.w = w.y; *(u32x4*)(ACT + (size_t)row * 2816 + ch0) = w4; }
                }
            }
        }
    }
};

struct EpiProj {
    static constexpr bool PERM = true, AFTER_DRAIN = false; static constexpr bool NEEDS_LDS = false; static __device__ __forceinline__ int row0(int pm) { return pm * BM; } static constexpr int MIDK_T = 0;
    bf16_t *P, *Q; const float* rope; const float* rs;
    __device__ __forceinline__ void operator()(const f32x4 (&acc)[2][2][4][2], const Unit& u, int wr, int wc, int fr, int fq) const {
        const int row0 = u.pm * BM + wr * 64 + fr;
        if (u.pn == 0) {
            const int col0 = wc * 32 + 8 * fq;
#pragma unroll
            for (int ai = 0; ai < 2; ++ai)
#pragma unroll
                for (int m = 0; m < 4; ++m) { bf16_t* rowp = P + (size_t)(row0 + ai * HALF + m * 16) * 256 + col0; const float rr = rs[row0 + ai * HALF + m * 16];
#pragma unroll
                    for (int bj = 0; bj < 2; ++bj) { const f32x4 v0 = acc[ai][bj][m][0] * rr, v1 = acc[ai][bj][m][1] * rr;
                        u32x4 w; w.x = cvt_pk_bf16(v0[0], v0[1]); w.y = cvt_pk_bf16(v0[2], v0[3]); w.z = cvt_pk_bf16(v1[0], v1[1]); w.w = cvt_pk_bf16(v1[2], v1[3]);
                        *(u32x4*)(rowp + bj * HALF) = w; } }
        } else {
            const int kind = (u.pn - 1) / 3, hb = ((u.pn - 1) % 3) * 4;
            bf16_t* T = Q + (size_t)kind * ((size_t)MTOK * 768);
            const bool do_rope = (kind < 2) && ((wc & 1) == 0);
            const float sc = kind == 0 ? C2 : 1.0f;
            const float sgn = fq == 0 ? -1.0f : 1.0f;
            const int dim0 = 32 * (wc & 1) + 8 * fq;
#pragma unroll
            for (int ai = 0; ai < 2; ++ai)
#pragma unroll
                for (int m = 0; m < 4; ++m) { const int row = row0 + ai * HALF + m * 16; const int t = row < NTOKP ? (row & 2047) : (row & 16383); const float rr = rs[row];
#pragma unroll
                    for (int bj = 0; bj < 2; ++bj) { f32x4 v0 = acc[ai][bj][m][0] * rr, v1 = acc[ai][bj][m][1] * rr;
                        if (do_rope) {
                            f32x4 p0, p1;
#pragma unroll
                            for (int j = 0; j < 4; ++j) {
                                auto a0 = __builtin_amdgcn_permlane16_swap(__float_as_uint(v0[j]), __float_as_uint(v0[j]), false, false);
                                auto a1 = __builtin_amdgcn_permlane16_swap(__float_as_uint(v1[j]), __float_as_uint(v1[j]), false, false);
                                p0[j] = __uint_as_float((fq & 1) ? a0[0] : a0[1]); p1[j] = __uint_as_float((fq & 1) ? a1[0] : a1[1]); }
                            if (fq < 2) { const f32x4 c0 = *(const f32x4*)(rope + t * 16), c1 = *(const f32x4*)(rope + t * 16 + 4), s0 = *(const f32x4*)(rope + t * 16 + 8), s1 = *(const f32x4*)(rope + t * 16 + 12);
                                v0 = v0 * c0 + (p0 * s0) * sgn; v1 = v1 * c1 + (p1 * s1) * sgn; }
                        }
                        v0 = v0 * sc; v1 = v1 * sc;
                        const int head = hb + 2 * bj + (wc >> 1);
                        u32x4 w; w.x = cvt_pk_bf16(v0[0], v0[1]); w.y = cvt_pk_bf16(v0[2], v0[3]); w.z = cvt_pk_bf16(v1[0], v1[1]); w.w = cvt_pk_bf16(v1[2], v1[3]);
                        *(u32x4*)(T + ((size_t)head * MTOK + row) * 64 + dim0) = w; } }
        }
    }
};

template <class Epi, class Sched, bool ALIGN_EPI = false, bool SP2 = false>
__device__ __forceinline__ void gemm_phase(PG8_LAS unsigned char* lds, const Gemm g, const Sched& S, const Epi& E) {
    int tid = threadIdx.x; asm volatile("" : "+v"(tid));
    const int wid = __builtin_amdgcn_readfirstlane(tid >> 6), lane = tid & 63, wr = wid >> 2, wc = wid & 3, fr = lane & 15, fq = lane >> 4;
    const int K = g.K, nt = K / BK;
    unsigned voffA[2], voffB[2];
#pragma unroll
    for (int i = 0; i < 2; ++i) { int R, C; stage_rc(tid * 16 + i * 8192, R, C); const int Rb = Epi::PERM ? ((R & ~31) + perm32(R & 31)) : R;
        voffA[i] = (unsigned)(R * K + C) * 2u; voffB[i] = (unsigned)(Rb * K + C) * 2u; }
    const size_t kstep = (size_t)(BK * 2);
    const size_t hstep = (size_t)HALF * K * 2;
    const size_t tstep = 2 * hstep;
    const unsigned ldsw = (unsigned)wid * 1024u;
    const int aoff = lds_byte(wr * 64 + fr, fq * 8), boff = lds_byte(wc * 32 + fr, fq * 8);
#define PG8_SA(b, h) (((b) * 2 + (h)) * HTB)
#define PG8_SB(b, h) ((4 + (b) * 2 + (h)) * HTB)
#define PG8_STAGE(bufoff, gbase, voff) do { _Pragma("unroll") for (int _i = 0; _i < 2; ++_i) \
        __builtin_amdgcn_global_load_lds((const unsigned*)((const char*)(gbase) + (voff)[_i]), (PG8_LAS unsigned*)(lds + (bufoff) + ldsw + _i * 8192), 16, 0, 0); } while (0)
#define PG8_LDA(dst, b, h) do { _Pragma("unroll") for (int m = 0; m < 4; ++m) _Pragma("unroll") for (int k = 0; k < 2; ++k) dst[m][k] = *(const PG8_LAS bf16x8*)(lds + PG8_SA(b, h) + aoff + m * 2048 + k * 1024); } while (0)
#define PG8_LDB(dst, b, h) do { _Pragma("unroll") for (int n = 0; n < 2; ++n) _Pragma("unroll") for (int k = 0; k < 2; ++k) dst[n][k] = *(const PG8_LAS bf16x8*)(lds + PG8_SB(b, h) + boff + n * 2048 + k * 1024); } while (0)
#define PG8_MMA(ai, bj, At, Bt) do { __builtin_amdgcn_s_setprio(1); _Pragma("unroll") for (int m = 0; m < 4; ++m) _Pragma("unroll") for (int n = 0; n < 2; ++n) _Pragma("unroll") for (int k = 0; k < 2; ++k) \
        acc[ai][bj][m][n] = __builtin_amdgcn_mfma_f32_16x16x32_bf16(Bt[n][k], At[m][k], acc[ai][bj][m][n], 0, 0, 0); __builtin_amdgcn_s_setprio(0); } while (0)
#define PG8_WAIT_V(n) asm volatile("s_waitcnt vmcnt(" #n ")" ::: "memory")
#define PG8_WAIT_L(n) asm volatile("s_waitcnt lgkmcnt(" #n ")" ::: "memory")
#define PG8_BAR __builtin_amdgcn_s_barrier()
#define PG8_SCHED __builtin_amdgcn_sched_barrier(0)
    Unit cur, nxt; int ui = 0;
    if (!S.next(0, cur)) return;
    f32x4 acc[2][2][4][2];
#pragma unroll
    for (int a = 0; a < 2; ++a)
#pragma unroll
        for (int b = 0; b < 2; ++b)
#pragma unroll
            for (int m = 0; m < 4; ++m)
#pragma unroll
                for (int n = 0; n < 2; ++n) acc[a][b][m][n] = (f32x4){0.f, 0.f, 0.f, 0.f};
    bf16x8 At[4][2], B0[2][2], B1[2][2];
    const long rstep = (long)K * 2;
    const char* cA = (const char*)g.A + (long)Epi::row0(cur.pm) * rstep; const char* cB = (const char*)g.Bt + (size_t)cur.pn * tstep;
    S.a_ready(cur);
    if constexpr (SP2) {
        PG8_STAGE(PG8_SB(0, 0), cB, voffB); PG8_STAGE(PG8_SB(0, 1), cB + hstep, voffB); PG8_STAGE(PG8_SA(0, 0), cA, voffA); PG8_STAGE(PG8_SA(0, 1), cA + hstep, voffA);
        if (wr == 1) PG8_BAR;
        PG8_WAIT_V(2); PG8_BAR;
        PG8_STAGE(PG8_SB(1, 0), cB + kstep, voffB); PG8_STAGE(PG8_SA(1, 0), cA + kstep, voffA); PG8_STAGE(PG8_SB(1, 1), cB + hstep + kstep, voffB);
        PG8_WAIT_V(6); PG8_BAR;
    } else {
        PG8_STAGE(PG8_SB(0, 0), cB, voffB); PG8_STAGE(PG8_SA(0, 0), cA, voffA); PG8_STAGE(PG8_SB(0, 1), cB + hstep, voffB); PG8_STAGE(PG8_SA(0, 1), cA + hstep, voffA);
        if (wr == 1) PG8_BAR;
        PG8_WAIT_V(4); PG8_BAR;
        PG8_STAGE(PG8_SB(1, 0), cB + kstep, voffB); PG8_STAGE(PG8_SA(1, 0), cA + kstep, voffA); PG8_STAGE(PG8_SB(1, 1), cB + hstep + kstep, voffB);
        PG8_WAIT_V(6); PG8_BAR;
    }
    for (;;) {
        const bool has_next = S.next(ui + 1, nxt);
        const char* nA = has_next ? (const char*)g.A + (long)Epi::row0(nxt.pm) * rstep : cA; const char* nB = has_next ? (const char*)g.Bt + (size_t)nxt.pn * tstep : cB;
        for (int t = 0; t < nt; t += 2) {
            const bool last = (t == nt - 2);
            const char* a1 = cA + (size_t)(t + 1) * kstep;
            const char* a2 = last ? nA : cA + (size_t)(t + 2) * kstep; const char* b2 = last ? nB : cB + (size_t)(t + 2) * kstep;
            const char* a3 = a2 + kstep; const char* b3 = b2 + kstep;
            if (last && has_next) S.a_ready(nxt);
            if constexpr (Epi::MIDK_T > 0) { if (t == Epi::MIDK_T) E.midk(acc, cur, wr, fr); }
            if constexpr (SP2) {
            PG8_LDB(B0, 0, 0); PG8_LDB(B1, 0, 1); PG8_SCHED; PG8_LDA(At, 0, 0); PG8_STAGE(PG8_SA(1, 1), a1 + hstep, voffA);
            PG8_WAIT_V(8); PG8_WAIT_L(0); PG8_BAR; PG8_MMA(0, 0, At, B0); PG8_MMA(0, 1, At, B1); PG8_BAR; PG8_SCHED;
            PG8_LDA(At, 0, 1); PG8_STAGE(PG8_SB(0, 0), b2, voffB); PG8_STAGE(PG8_SB(0, 1), b2 + hstep, voffB); PG8_STAGE(PG8_SA(0, 0), a2, voffA);
            PG8_WAIT_V(8); PG8_WAIT_L(0); PG8_BAR; PG8_MMA(1, 0, At, B0); PG8_MMA(1, 1, At, B1); PG8_BAR; PG8_SCHED;
            PG8_LDB(B0, 1, 0); PG8_LDB(B1, 1, 1); PG8_SCHED; PG8_LDA(At, 1, 0); PG8_STAGE(PG8_SA(0, 1), a2 + hstep, voffA);
            PG8_WAIT_V(8); PG8_WAIT_L(0); PG8_BAR; PG8_MMA(0, 0, At, B0); PG8_MMA(0, 1, At, B1); PG8_BAR; PG8_SCHED;
            PG8_LDA(At, 1, 1); PG8_STAGE(PG8_SB(1, 0), b3, voffB); PG8_STAGE(PG8_SB(1, 1), b3 + hstep, voffB); PG8_STAGE(PG8_SA(1, 0), a3, voffA);
            PG8_WAIT_V(8); PG8_WAIT_L(0); PG8_BAR; PG8_MMA(1, 0, At, B0); PG8_MMA(1, 1, At, B1); PG8_BAR; PG8_SCHED;
            } else {
            PG8_LDB(B0, 0, 0); PG8_SCHED; PG8_LDA(At, 0, 0); PG8_STAGE(PG8_SA(1, 1), a1 + hstep, voffA);
            PG8_WAIT_L(8); PG8_BAR; PG8_WAIT_L(0); PG8_MMA(0, 0, At, B0); PG8_BAR; PG8_SCHED;
            PG8_LDB(B1, 0, 1); PG8_STAGE(PG8_SB(0, 0), b2, voffB);
            PG8_BAR; PG8_WAIT_L(0); PG8_MMA(0, 1, At, B1); PG8_BAR;
            PG8_LDA(At, 0, 1); PG8_STAGE(PG8_SA(0, 0), a2, voffA);
            PG8_BAR; PG8_WAIT_L(0); PG8_MMA(1, 0, At, B0); PG8_BAR; PG8_SCHED;
            PG8_STAGE(PG8_SB(0, 1), b2 + hstep, voffB);
            PG8_WAIT_V(6); PG8_BAR; PG8_MMA(1, 1, At, B1); PG8_BAR;
            PG8_LDB(B0, 1, 0); PG8_SCHED; PG8_LDA(At, 1, 0); PG8_STAGE(PG8_SA(0, 1), a2 + hstep, voffA);
            PG8_WAIT_L(8); PG8_BAR; PG8_WAIT_L(0); PG8_MMA(0, 0, At, B0); PG8_BAR; PG8_SCHED;
            PG8_LDB(B1, 1, 1); PG8_STAGE(PG8_SB(1, 0), b3, voffB);
            PG8_BAR; PG8_WAIT_L(0); PG8_MMA(0, 1, At, B1); PG8_BAR;
            PG8_LDA(At, 1, 1); PG8_STAGE(PG8_SA(1, 0), a3, voffA);
            PG8_BAR; PG8_WAIT_L(0); PG8_MMA(1, 0, At, B0); PG8_BAR; PG8_SCHED;
            PG8_STAGE(PG8_SB(1, 1), b3 + hstep, voffB);
            PG8_WAIT_V(6); PG8_BAR; PG8_MMA(1, 1, At, B1); PG8_BAR;
            }
        }
        if constexpr (ALIGN_EPI) { if (wr == 0) PG8_BAR; }
        if constexpr (!Epi::AFTER_DRAIN) { if constexpr (Epi::NEEDS_LDS) E.run(acc, cur, wr, wc, lds + 132096); else E(acc, cur, wr, wc, fr, fq); S.done(cur); }
        if (!has_next) break;
#pragma unroll
        for (int a = 0; a < 2; ++a)
#pragma unroll
            for (int b = 0; b < 2; ++b)
#pragma unroll
                for (int m = 0; m < 4; ++m)
#pragma unroll
                    for (int n = 0; n < 2; ++n) acc[a][b][m][n] = (f32x4){0.f, 0.f, 0.f, 0.f};
        cur = nxt; cA = nA; cB = nB; ++ui;
        if constexpr (ALIGN_EPI) { if (wr == 1) PG8_BAR; }
    }
    PG8_WAIT_V(0);
    if constexpr (!ALIGN_EPI) { if (wr == 0) PG8_BAR; }
    PG8_BAR;
#undef PG8_SA
#undef PG8_SB
#undef PG8_STAGE
#undef PG8_LDA
#undef PG8_LDB
#undef PG8_MMA
#undef PG8_WAIT_V
#undef PG8_WAIT_L
#undef PG8_BAR
#undef PG8_SCHED
}
}

constexpr int NWAVES = 8, NTHR = 512;
constexpr int DM = 1024, M = 49152, NTP = 16384, SP = 2048, SS = 16384;
constexpr int NIN = 2560, DFF = 2816, NUP = 5632, NH = 12, HD = 64, PW = 256;
constexpr float EPS = 1e-6f;

constexpr size_t MiB = 1u << 20;
constexpr size_t WS_CTL = 0, CTL_ZERO_BYTES = 65536;
constexpr size_t WS_ROPE = 1 * MiB;
constexpr size_t WS_WIN = 2 * MiB, WS_WOUT = 8 * MiB, WS_WUP = 10 * MiB, WS_WDN = 21 * MiB;
constexpr size_t WS_SSQ = 27 * MiB;
constexpr size_t WS_RS1 = 30 * MiB, WS_RS2 = 31 * MiB;
constexpr size_t WS_H = 32 * MiB;
constexpr size_t WS_P = 128 * MiB, WS_Q = 152 * MiB, WS_K = 224 * MiB, WS_V = 296 * MiB, WS_Y = 128 * MiB;
constexpr size_t WS_X1 = 392 * MiB;
constexpr size_t WS_ACT = 128 * MiB, WS_Z = 32 * MiB, WS_END = 489 * MiB;
constexpr int CW_BAR = 4096;

constexpr int RING_BYTES = 131072, LDS_BYTES = 163840, LDSCTL_OFF = LDS_BYTES - 1024, MISC_OFF = LDSCTL_OFF + 320;

#define GAS __attribute__((address_space(1)))
#define LAS __attribute__((address_space(3)))
typedef unsigned short bf16;
typedef unsigned v4u __attribute__((ext_vector_type(4)));
typedef unsigned v2u __attribute__((ext_vector_type(2)));
typedef float f32x4 __attribute__((ext_vector_type(4)));
#define LDS_WAIT() asm volatile("s_waitcnt lgkmcnt(0)" ::: "memory")

__device__ __forceinline__ unsigned f2bf(float f) { unsigned u = __builtin_bit_cast(unsigned, f); return (u + 0x7fffu + ((u >> 16) & 1u)) >> 16; }
__device__ __forceinline__ unsigned pk2(float lo, float hi) { return f2bf(lo) | (f2bf(hi) << 16); }
__device__ __forceinline__ float bflo(unsigned w) { return __builtin_bit_cast(float, w << 16); }
__device__ __forceinline__ float bfhi(unsigned w) { return __builtin_bit_cast(float, w & 0xffff0000u); }

#define XB_TMO      128
#define XB_XCNT(j)  (256  + 64 * (j))
#define XB_XSUB(j)  (1280 + 64 * (j))
#define XB_XGEN(j)  (2304 + 64 * (j))
#define XB_TOP      3328
#define XB_TOPGEN   3392
#define XCD_BAR_WORDS 3456
#define XB_SPIN_CAP (1u << 18)
__device__ __forceinline__ unsigned xb_ld(unsigned* p)              { return __hip_atomic_load(p, __ATOMIC_RELAXED, __HIP_MEMORY_SCOPE_AGENT); }
__device__ __forceinline__ unsigned xb_add(unsigned* p, unsigned v) { return __hip_atomic_fetch_add(p, v, __ATOMIC_RELAXED, __HIP_MEMORY_SCOPE_AGENT); }
__device__ __forceinline__ unsigned xb_xcc_id() { return (unsigned)__builtin_amdgcn_s_getreg((3 << 11) | 20) & 0xFu; }
#define XB_SPIN(cond, bar) do { unsigned _sp = 0; while (cond) { __builtin_amdgcn_s_sleep(1); \
    if ((++_sp & 255u) == 0u) { if (xb_ld(&(bar)[XB_TMO])) break; if (_sp > XB_SPIN_CAP) { atomicAdd(&(bar)[XB_TMO], 1u); break; } } } } while (0)
struct XcdBarrier { unsigned* bar; unsigned x; volatile LAS unsigned* st; };
__device__ __forceinline__ XcdBarrier xcd_barrier_post(unsigned* bar, volatile LAS unsigned* st) {
    XcdBarrier b; b.bar = bar; b.x = xb_xcc_id(); b.st = st;
    if (threadIdx.x == 0) (void)xb_add(&bar[XB_XCNT(b.x)], 1u);
    return b;
}
__device__ __forceinline__ void xcd_barrier_complete(unsigned* bar, unsigned x, unsigned& nloc, unsigned& nx) {
    const unsigned G = gridDim.x * gridDim.y * gridDim.z;
    unsigned sum, cnt, mine, sp = 0u;
    for (;;) {
        sum = 0u; cnt = 0u; mine = 0u;
#pragma unroll
        for (unsigned j = 0; j < 16; ++j) { const unsigned c = xb_ld(&bar[XB_XCNT(j)]); sum += c; cnt += (c > 0u) ? 1u : 0u; mine = (j == x) ? c : mine; }
        if (sum == G) break;
        __builtin_amdgcn_s_sleep(1);
        if ((++sp & 255u) == 0u) { if (xb_ld(&bar[XB_TMO])) break; if (sp > XB_SPIN_CAP) { atomicAdd(&bar[XB_TMO], 1u); break; } }
    }
    nloc = mine > 0u ? mine : 1u; nx = cnt > 0u ? cnt : 1u;
}
__device__ __forceinline__ void xcd_barrier(const XcdBarrier& b) {
    asm volatile("s_waitcnt vmcnt(0)" ::: "memory");
    __syncthreads();
    if (threadIdx.x == 0) {
        unsigned* bar = b.bar;
        __builtin_amdgcn_s_waitcnt(0);
        unsigned nloc = b.st[0], nx = b.st[1];
        if (nloc == 0u) { xcd_barrier_complete(bar, b.x, nloc, nx); b.st[0] = nloc; b.st[1] = nx; }
        const unsigned old = xb_add(&bar[XB_XSUB(b.x)], 1u);
        const unsigned gen = old / nloc;
        if (old + 1u == (gen + 1u) * nloc) {
            __builtin_amdgcn_fence(__ATOMIC_RELEASE, "agent");
            asm volatile("s_waitcnt vmcnt(0)" ::: "memory");
            const unsigned og = xb_add(&bar[XB_TOP], 1u);
            const unsigned tg = og / nx;
            if (og + 1u == (tg + 1u) * nx) xb_add(&bar[XB_TOPGEN], 1u);
            else XB_SPIN(xb_ld(&bar[XB_TOPGEN]) == tg, bar);
            __builtin_amdgcn_fence(__ATOMIC_ACQUIRE, "agent");
            xb_add(&bar[XB_XGEN(b.x)], 1u);
            asm volatile("s_waitcnt vmcnt(0)" ::: "memory");
        } else {
            XB_SPIN(xb_ld(&bar[XB_XGEN(b.x)]) == gen, bar);
            __builtin_amdgcn_fence(__ATOMIC_ACQUIRE, "agent");
            asm volatile("s_waitcnt vmcnt(0)" ::: "memory");
        }
    }
    __syncthreads();
}

__device__ __forceinline__ float wave_sum(float v) {
#pragma unroll
    for (int o = 1; o < 64; o <<= 1) v += __shfl_xor(v, o);
    return v;
}
__device__ __forceinline__ const float* xrow_ptr(const float* xp, const float* xs, int m) { return m < NTP ? xp + (size_t)m * DM : xs + (size_t)(m - NTP) * DM; }
__device__ __forceinline__ void seq_of(int m, int& s0, int& S) { if (m < NTP) { s0 = m & ~(SP - 1); S = SP; } else { s0 = NTP + ((m - NTP) & ~(SS - 1)); S = SS; } }

__device__ __forceinline__ void p0_transpose_item(const float* W, int K, int N, bf16* WT, LAS float* scr, int item, int lane, const float* ga = nullptr, const float* gb = nullptr, int gsplit = 0, bool upmap = false) {
    const int nblk = N / 32, kb = item / nblk, nb = item % nblk, k0 = 64 * kb, n0 = 32 * nb;
    int nd0 = n0; if (upmap) { const int bj = n0 >= DFF ? 1 : 0, ch = n0 - DFF * bj; nd0 = 256 * (ch >> 7) + 128 * bj + (ch & 127); }
#pragma unroll 8
    for (int i = 0; i < 32; ++i) { const int kk = 2 * i + (lane >> 5); float wv = __builtin_nontemporal_load(W + (size_t)(k0 + kk) * N + n0 + (lane & 31));
        if (ga) { const int k = k0 + kk; wv *= (k < gsplit ? ga[k] : gb[k - gsplit]); }
        scr[kk * 33 + (lane & 31)] = wv; }
    LDS_WAIT(); asm volatile("" ::: "memory");
    const int c = lane & 7;
#pragma unroll
    for (int j = 0; j < 4; ++j) { const int n = (lane >> 3) + 8 * j; const LAS float* s = scr + (8 * c) * 33 + n;
        v4u o; o.x = pk2(s[0 * 33], s[1 * 33]); o.y = pk2(s[2 * 33], s[3 * 33]); o.z = pk2(s[4 * 33], s[5 * 33]); o.w = pk2(s[6 * 33], s[7 * 33]);
        *(v4u*)(WT + (size_t)(nd0 + n) * K + k0 + 8 * c) = o; }
    LDS_WAIT(); asm volatile("" ::: "memory");
}

__constant__ double ROPE_REV[8] = {0.15915494309189535, 0.03086376340470123, 0.005985185712713705, 0.001160663641240061,
                                   0.00022507907903927653, 4.364795279280289e-05, 8.464330808241401e-06, 1.6414262627950345e-06};

__device__ __forceinline__ float rows_max(float v) {
    auto a = __builtin_amdgcn_permlane16_swap(__float_as_uint(v), __float_as_uint(v), false, false); v = fmaxf(__uint_as_float(a[0]), __uint_as_float(a[1]));
    auto b = __builtin_amdgcn_permlane32_swap(__float_as_uint(v), __float_as_uint(v), false, false); return fmaxf(__uint_as_float(b[0]), __uint_as_float(b[1]));
}
__device__ __forceinline__ float rows_sum(float v) {
    auto a = __builtin_amdgcn_permlane16_swap(__float_as_uint(v), __float_as_uint(v), false, false); v = __uint_as_float(a[0]) + __uint_as_float(a[1]);
    auto b = __builtin_amdgcn_permlane32_swap(__float_as_uint(v), __float_as_uint(v), false, false); return __uint_as_float(b[0]) + __uint_as_float(b[1]);
}
struct Args { const float* in[16]; float* out; unsigned char* ws; };

__global__ void __launch_bounds__(NTHR, 2) hymba_fwd(Args args) {
    extern __shared__ __attribute__((aligned(16))) unsigned char lds[];
    cg::grid_group grid = cg::this_grid();
    LAS unsigned char* L = (LAS unsigned char*)lds;
    const int tid = threadIdx.x, lane = tid & 63, wave = __builtin_amdgcn_readfirstlane(tid >> 6);
    const int G = gridDim.x, bx = blockIdx.x;
    const int vcu = (G % 8 == 0) ? (bx % 8) * (G / 8) + bx / 8 : bx;
    const int gw = vcu * NWAVES + wave, NGW = G * NWAVES;
#define xp (args.in[0])
#define xs (args.in[1])
#define g_mix_pre (args.in[2])
#define g_mix_post (args.in[3])
#define w_in (args.in[4])
#define pool_w (args.in[5])
#define pool_scale (args.in[6])
#define g_pool_out (args.in[7])
#define g_attn_out (args.in[8])
#define w_out (args.in[9])
#define g_ffn_pre (args.in[10])
#define g_ffn_post (args.in[11])
#define w_up (args.in[12])
#define conv_w (args.in[13])
#define conv_b (args.in[14])
#define w_down (args.in[15])
#define out (args.out)
#define ws (args.ws)
#define Wt_in ((bf16*)(ws + WS_WIN))
#define Wt_out ((bf16*)(ws + WS_WOUT))
#define Wt_up ((bf16*)(ws + WS_WUP))
#define Wt_dn ((bf16*)(ws + WS_WDN))
#define rope ((float*)(ws + WS_ROPE))
#define Hb ((bf16*)(ws + WS_H))
#define Pb ((bf16*)(ws + WS_P))
#define Qb ((bf16*)(ws + WS_Q))
#define Kb ((bf16*)(ws + WS_K))
#define Vb ((bf16*)(ws + WS_V))
#define Yb ((bf16*)(ws + WS_Y))
#define ACTb ((bf16*)(ws + WS_ACT))
#define Zb ((bf16*)(ws + WS_Z))
#define SSQ ((float*)(ws + WS_SSQ))
#define RS1 ((float*)(ws + WS_RS1))
#define RS2 ((float*)(ws + WS_RS2))
#define MIXb ((bf16*)(ws + WS_X1))
#define X1b ((bf16*)(ws + WS_X1))

    for (int u = tid; u < (LDS_BYTES - LDSCTL_OFF) / 4; u += NTHR) ((LAS unsigned*)(L + LDSCTL_OFF))[u] = 0u;
    __syncthreads();
#if !USE_CG_SYNC
    XcdBarrier bar = xcd_barrier_post((unsigned*)(ws + WS_CTL) + CW_BAR, (volatile LAS unsigned*)(L + MISC_OFF) + 8);
#define GRID_BAR() xcd_barrier(bar)
#else
#define GRID_BAR() grid.sync()
#endif
#define GRID_BAR_CG() grid.sync()

#ifndef SKIP_P0
    {
        int tid0 = threadIdx.x; asm volatile("" : "+v"(tid0)); const int tid = tid0, lane = tid0 & 63;
        LAS float* scr = (LAS float*)(L + wave * 16384);
        constexpr int I_IN = (DM / 64) * (NIN / 32), I_OUT = (DM / 64) * (DM / 32), I_UP = (DM / 64) * (NUP / 32), I_DN = (DFF / 64) * (DM / 32);
        constexpr int NITEMS = I_IN + I_OUT + I_UP + I_DN;
        for (int it = gw; it < NITEMS; it += NGW) {
            int r = it;
            if (r < I_IN) { p0_transpose_item(w_in, DM, NIN, Wt_in, scr, r, lane, g_mix_pre, g_mix_pre, DM); continue; } r -= I_IN;
            if (r < I_OUT) { p0_transpose_item(w_out, DM, DM, Wt_out, scr, r, lane, g_pool_out, g_attn_out, PW); continue; } r -= I_OUT;
            if (r < I_UP) { p0_transpose_item(w_up, DM, NUP, Wt_up, scr, r, lane, g_ffn_pre, g_ffn_pre, DM, true); continue; } r -= I_UP;
            p0_transpose_item(w_down, DFF, DM, Wt_dn, scr, r, lane);
        }
        for (int idx = bx * NTHR + tid; idx < SS * 8; idx += G * NTHR) {
            const int t = idx >> 3, i = idx & 7;
            double x = (double)t * ROPE_REV[i]; x -= __builtin_rint(x);
            const float xf = (float)x;
            rope[t * 16 + i] = __builtin_amdgcn_cosf(xf); rope[t * 16 + 8 + i] = __builtin_amdgcn_sinf(xf);
        }
        for (int mb = gw; mb < M; mb += 4 * NGW) {
            f32x4 v[4][4];
#pragma unroll
            for (int k = 0; k < 4; ++k) { const f32x4* xr = (const f32x4*)xrow_ptr(xp, xs, mb + k * NGW) + lane;
#pragma unroll
                for (int j = 0; j < 4; ++j) v[k][j] = __builtin_nontemporal_load(xr + 64 * j); }
#pragma unroll
            for (int k = 0; k < 4; ++k) { const int m = mb + k * NGW; float sq = 0.f;
#pragma unroll
                for (int j = 0; j < 4; ++j) sq += (v[k][j].x * v[k][j].x + v[k][j].y * v[k][j].y) + (v[k][j].z * v[k][j].z + v[k][j].w * v[k][j].w);
                const float r = 1.f / sqrtf(wave_sum(sq) * (1.f / DM) + EPS);
                if (lane == 0) RS1[m] = r;
                unsigned long long* o8 = (unsigned long long*)(Hb + (size_t)m * DM) + lane;
#pragma unroll
                for (int j = 0; j < 4; ++j) o8[64 * j] = (unsigned long long)pk2(v[k][j].x, v[k][j].y) | ((unsigned long long)pk2(v[k][j].z, v[k][j].w) << 32); }
        }
    }
#endif
    GRID_BAR();
    if (gridDim.x > 65535u) GRID_BAR_CG();

#ifndef SKIP_P1
    {
        pg8::Gemm g{Hb, Wt_in, M, NIN, DM}; pg8::StaticOrder S; S.init(M, NIN, G, bx);
        pg8::EpiProj E{Pb, Qb, rope, RS1};
        pg8::gemm_phase<pg8::EpiProj, pg8::StaticOrder, true, true>(L, g, S, E);
    }
#endif
    GRID_BAR();

#ifndef SKIP_P2A
    {
        int tida = threadIdx.x; asm volatile("" : "+v"(tida));
        const int lane_a = tida & 63, fr = lane_a & 15, fq = lane_a >> 4, vrow = lane_a >> 3, vch = lane_a & 7;
        LAS unsigned char* OACC = L;
        LAS float* MLA = (LAS float*)(L + 65536);
        LAS unsigned char* VST = L + 67584 + wave * 10240;
        constexpr int NUNIT = NH * (M / 256);
        const int nu = vcu < NUNIT ? (NUNIT - vcu + G - 1) / G : 0, nj = nu * 6;
        typedef short s16x4 __attribute__((ext_vector_type(4)));
        typedef short v4i16_t __attribute__((ext_vector_type(4)));
#define ATT_PARAMS(J, h_, m0_, S_, B_, Bo_, d_, p_, off_) do { const int ui_ = (J) / 6, jb_ = (J) - 6 * ui_; const int unit_ = ui_ * G + vcu; h_ = unit_ / (M / 256); m0_ = (unit_ % (M / 256)) * 256; \
            int s0_; seq_of(m0_, s0_, S_); p_ = jb_ >> 1; const int tau_ = wave + 8 * (jb_ & 1); d_ = p_ == 0 ? 1 : (p_ == 1 ? 4 : 16); \
            Bo_ = p_ == 0 ? 16 * tau_ : (p_ == 1 ? 64 * (tau_ >> 2) + (tau_ & 3) : tau_); B_ = (m0_ - s0_) + Bo_; off_ = ((size_t)h_ * M + s0_) * 64; } while (0)
        const unsigned vsw = 16u * (unsigned)(vch ^ (((vrow >> 1) & 3) << 1));
#define ATT_SLOT(i_) ((sb + ((i_) % 5) >= 5 ? sb + ((i_) % 5) - 5 : sb + ((i_) % 5)) << 11)
#define ATT_ISSUE(g_, i_, B_, d_, S_, off_) do { \
            _Pragma("unroll") for (int j = 0; j < 2; ++j) { const int r_ = 8 * j + vrow; const char* src_; \
                if ((i_) == 0) { src_ = (const char*)(Qb + (off_)) + ((unsigned)((B_) + (d_) * r_) * 128u + 16u * (unsigned)(vch ^ ((4 * j + (vrow >> 1)) & 7))); } \
                else if ((i_) < 10) { const unsigned tk = (unsigned)min(max((B_) + (d_) * (16 * ((i_) - 1) + r_ - 64), 0), (S_) - 1); src_ = (const char*)(Kb + (off_)) + (tk * 128u + 16u * (unsigned)(vch ^ ((4 * j + (vrow >> 1)) & 7))); } \
                else { const unsigned tk = (unsigned)min(max((B_) + (d_) * (16 * ((i_) - 10) + r_ - 64), 0), (S_) - 1); src_ = (const char*)(Vb + (off_)) + (tk * 128u + vsw); } \
                __builtin_amdgcn_global_load_lds((const unsigned*)src_, (LAS unsigned*)(VST + ATT_SLOT(g_) + j * 1024), 16, 0, 0); } } while (0)
#define ATT_AHEAD(i_) do { asm volatile("s_waitcnt lgkmcnt(0)" ::: "memory"); if ((i_) < 19) ATT_ISSUE((i_), (i_), B, d, S, off); else ATT_ISSUE((i_), (i_) - 19, Bn, dn, Sn, offn); } while (0)
#define ATT_READY() asm volatile("s_waitcnt vmcnt(8)" ::: "memory")
        pg8::bf16x8 qf[2];
        int h = 0, m0 = 0, S = 1, B = 0, Bo = 0, d = 1, p = 0; size_t off = 0;
        int sb = 0;
        if (nj > 0) { ATT_PARAMS(0, h, m0, S, B, Bo, d, p, off); ATT_ISSUE(0, 0, B, d, S, off); ATT_ISSUE(1, 1, B, d, S, off); ATT_ISSUE(2, 2, B, d, S, off); ATT_ISSUE(3, 3, B, d, S, off); }
#pragma unroll 1
        for (int J = 0; J < nj; ++J) {
            int hn, m0n, Sn, Bn, Bon, dn, pn; size_t offn; { const int Jn = J + 1 < nj ? J + 1 : J; ATT_PARAMS(Jn, hn, m0n, Sn, Bn, Bon, dn, pn, offn); }
            f32x4 sc[9];
            { ATT_AHEAD(4); ATT_READY(); const LAS unsigned char* sl = VST + ATT_SLOT(0); const int ks_ = (fr >> 1) & 7;
              qf[0] = *(const LAS pg8::bf16x8*)(sl + fr * 128 + 16 * (fq ^ ks_)); qf[1] = *(const LAS pg8::bf16x8*)(sl + fr * 128 + 16 * ((fq + 4) ^ ks_)); }
#pragma unroll
            for (int kb = 0; kb < 9; ++kb) { ATT_AHEAD(kb + 5); ATT_READY();
                const LAS unsigned char* sl = VST + ATT_SLOT(1 + kb); const int ks_ = (fr >> 1) & 7;
                const pg8::bf16x8 k0 = *(const LAS pg8::bf16x8*)(sl + fr * 128 + 16 * (fq ^ ks_)), k1 = *(const LAS pg8::bf16x8*)(sl + fr * 128 + 16 * ((fq + 4) ^ ks_));
                f32x4 c = (f32x4){0.f, 0.f, 0.f, 0.f};
                c = __builtin_amdgcn_mfma_f32_16x16x32_bf16(k0, qf[0], c, 0, 0, 0);
                c = __builtin_amdgcn_mfma_f32_16x16x32_bf16(k1, qf[1], c, 0, 0, 0); sc[kb] = c; }
#pragma unroll
            for (int r = 0; r < 4; ++r) { if (4 * fq + r < fr) sc[0][r] = -INFINITY; if (4 * fq + r > fr) sc[8][r] = -INFINITY; }
            if (B - 64 * d < 0 || B + 79 * d >= S) {
                const int klo = 64 - (B >> (2 * p)), khi = 64 + ((S - 1 - B) >> (2 * p));
                const int lo_l = klo - 4 * fq, hi_l = khi - 4 * fq;
#pragma unroll
                for (int kb = 0; kb < 9; ++kb)
#pragma unroll
                    for (int r = 0; r < 4; ++r) { if (16 * kb + r < lo_l || 16 * kb + r > hi_l) sc[kb][r] = -INFINITY; }
            }
            float mx = __builtin_fmaxf(__builtin_fmaxf(sc[0][0], sc[0][1]), __builtin_fmaxf(sc[0][2], sc[0][3]));
#pragma unroll
            for (int kb = 1; kb < 9; ++kb) { mx = __builtin_fmaxf(__builtin_fmaxf(mx, sc[kb][0]), sc[kb][1]); mx = __builtin_fmaxf(__builtin_fmaxf(mx, sc[kb][2]), sc[kb][3]); }
            mx = rows_max(mx);
            float ls = 0.f;
            s16x4 pf[9];
#pragma unroll
            for (int kb = 0; kb < 9; ++kb) { f32x4 e;
#pragma unroll
                for (int r = 0; r < 4; ++r) { e[r] = __builtin_amdgcn_exp2f(sc[kb][r] - mx); ls += e[r]; }
                v2u w; w.x = pg8::cvt_pk_bf16(e[0], e[1]); w.y = pg8::cvt_pk_bf16(e[2], e[3]); pf[kb] = __builtin_bit_cast(s16x4, w); }
            ls = rows_sum(ls);
            f32x4 o[4];
#pragma unroll
            for (int nb = 0; nb < 4; ++nb) o[nb] = (f32x4){0.f, 0.f, 0.f, 0.f};
#pragma unroll
            for (int kb = 0; kb < 9; ++kb) { ATT_AHEAD(kb + 14); ATT_READY();
                const LAS unsigned char* sl = VST + ATT_SLOT(10 + kb);
                const int R = 4 * fq + (fr >> 2), pp = fr & 3;
                s16x4 vt[4];
#pragma unroll
                for (int nb = 0; nb < 4; ++nb) { const unsigned a_ = (unsigned)(size_t)(sl + R * 128 + 16 * ((2 * nb + (pp >> 1)) ^ (((R >> 1) & 3) << 1)) + 8 * (pp & 1));
                    asm volatile("ds_read_b64_tr_b16 %0, %1" : "=v"(vt[nb]) : "v"(a_) : "memory"); }
                asm volatile("s_waitcnt lgkmcnt(0)" ::: "memory"); __builtin_amdgcn_sched_barrier(0);
#pragma unroll
                for (int nb = 0; nb < 4; ++nb) o[nb] = __builtin_amdgcn_mfma_f32_16x16x16bf16_1k(vt[nb], pf[kb], o[nb], 0, 0, 0);
            }
            const int u = Bo + d * fr, sw = (u ^ (u >> 4)) & 15;
            if (p > 0) {
                const float ma = MLA[2 * u], la = MLA[2 * u + 1];
                const float mn = fmaxf(ma, mx), fa = __builtin_amdgcn_exp2f(ma - mn), fb = __builtin_amdgcn_exp2f(mx - mn);
                ls = la * fa + ls * fb; mx = mn;
#pragma unroll
                for (int nb = 0; nb < 4; ++nb) { const f32x4 oa = *(LAS f32x4*)(OACC + u * 256 + 16 * ((4 * nb + fq) ^ sw)); o[nb] = oa * fa + o[nb] * fb; }
            }
            if (p < 2) {
                if (fq == 0) { MLA[2 * u] = mx; MLA[2 * u + 1] = ls; }
#pragma unroll
                for (int nb = 0; nb < 4; ++nb) *(LAS f32x4*)(OACC + u * 256 + 16 * ((4 * nb + fq) ^ sw)) = o[nb];
            } else {
                const float inv = 1.f / ls;
                bf16* op = MIXb + (size_t)(m0 + u) * DM + PW + h * 64 + 4 * fq;
                float sq = 0.f;
#pragma unroll
                for (int nb = 0; nb < 4; ++nb) { const f32x4 ov = o[nb] * inv; sq += (ov[0] * ov[0] + ov[1] * ov[1]) + (ov[2] * ov[2] + ov[3] * ov[3]);
                    v2u w; w.x = pg8::cvt_pk_bf16(ov[0], ov[1]); w.y = pg8::cvt_pk_bf16(ov[2], ov[3]); *(v2u*)(op + 16 * nb) = w; }
                sq = rows_sum(sq);
                if (fq == 0) SSQ[(size_t)(m0 + u) * NH + h] = sq;
            }
            if ((J & 1) == 1) { asm volatile("s_waitcnt lgkmcnt(0)" ::: "memory"); __builtin_amdgcn_s_barrier(); asm volatile("" ::: "memory"); }
            h = hn; m0 = m0n; S = Sn; B = Bn; Bo = Bon; d = dn; p = pn; off = offn;
            sb = sb + 4 >= 5 ? sb - 1 : sb + 4;
        }
        asm volatile("s_waitcnt vmcnt(0)" ::: "memory"); __syncthreads();
#undef ATT_PARAMS
#undef ATT_ISSUE
#undef ATT_SLOT
#undef ATT_AHEAD
#undef ATT_READY
    }
#endif
#ifndef SKIP_P2B
    {
        int tidp = threadIdx.x; asm volatile("" : "+v"(tidp));
        const int lp = tidp & 63, fr = lp & 15, fq = lp >> 4;
        constexpr int PPITCH = 528;
        LAS unsigned char* PST = L;
        LAS unsigned char* POOL = L + 80 * PPITCH;
        LAS float* SSP = (LAS float*)(L + 144 * PPITCH);
        const int g = wave & 3, th = wave >> 2;
        pg8::bf16x8 wf[4][2];
#pragma unroll
        for (int eb = 0; eb < 4; ++eb)
#pragma unroll
            for (int ks = 0; ks < 2; ++ks) { const float* wp = pool_w + ((size_t)(g * 64 + 32 * ks + 8 * fq) * 64 + 16 * eb + fr);
                v4u w; w.x = pk2(wp[0], wp[64]); w.y = pk2(wp[128], wp[192]); w.z = pk2(wp[256], wp[320]); w.w = pk2(wp[384], wp[448]); wf[eb][ks] = __builtin_bit_cast(pg8::bf16x8, w); }
        for (int item = bx; item < M / 64; item += G) {
            const int m0 = item * 64;
            int s0, S; seq_of(m0, s0, S);
            const int t0 = m0 - s0;
            for (int q = tidp; q < 80 * 32; q += NTHR) { const int row = q >> 5, ch = q & 31; const int t = t0 - 8 + row;
                if (t >= 0 && t < S) *(LAS v4u*)(PST + row * PPITCH + 16 * ch) = *(const v4u*)(Pb + (size_t)(s0 + t) * PW + 8 * ch); }
            __syncthreads();
            { const int tok = tidp >> 3, part = tidp & 7, gg = part >> 1, hw = 1 << gg; const int t = t0 + tok;
              const int lo = (t - hw) > 0 ? (t - hw) : 0, hi = (t + hw) < S ? (t + hw) : S;
              float sum[32];
#pragma unroll
              for (int i = 0; i < 32; ++i) sum[i] = 0.f;
              for (int tr = lo; tr < hi; ++tr) { const LAS v4u* rp = (const LAS v4u*)(PST + (tr - t0 + 8) * PPITCH + 64 * part);
#pragma unroll
                  for (int c = 0; c < 4; ++c) { const v4u w = rp[c]; sum[8 * c + 0] += bflo(w.x); sum[8 * c + 1] += bfhi(w.x); sum[8 * c + 2] += bflo(w.y); sum[8 * c + 3] += bfhi(w.y);
                      sum[8 * c + 4] += bflo(w.z); sum[8 * c + 5] += bfhi(w.z); sum[8 * c + 6] += bflo(w.w); sum[8 * c + 7] += bfhi(w.w); } }
              const float rc = 1.f / (float)(hi - lo);
              const LAS v4u* cp = (const LAS v4u*)(PST + (tok + 8) * PPITCH + 64 * part);
#pragma unroll
              for (int c = 0; c < 4; ++c) { const v4u w = cp[c]; v4u o;
                  o.x = pk2(sum[8 * c + 0] * rc - bflo(w.x), sum[8 * c + 1] * rc - bfhi(w.x)); o.y = pk2(sum[8 * c + 2] * rc - bflo(w.y), sum[8 * c + 3] * rc - bfhi(w.y));
                  o.z = pk2(sum[8 * c + 4] * rc - bflo(w.z), sum[8 * c + 5] * rc - bfhi(w.z)); o.w = pk2(sum[8 * c + 6] * rc - bflo(w.w), sum[8 * c + 7] * rc - bfhi(w.w));
                  *(LAS v4u*)(POOL + tok * PPITCH + 64 * part + 16 * c) = o; } }
            __syncthreads();
            f32x4 acc[2][4];
#pragma unroll
            for (int tb = 0; tb < 2; ++tb) {
                const LAS unsigned char* prow = POOL + (32 * th + 16 * tb + fr) * PPITCH + 128 * g + 16 * fq;
                const pg8::bf16x8 b0 = *(const LAS pg8::bf16x8*)(prow), b1 = *(const LAS pg8::bf16x8*)(prow + 64);
#pragma unroll
                for (int eb = 0; eb < 4; ++eb) { f32x4 c = (f32x4){0.f, 0.f, 0.f, 0.f};
                    c = __builtin_amdgcn_mfma_f32_16x16x32_bf16(wf[eb][0], b0, c, 0, 0, 0); c = __builtin_amdgcn_mfma_f32_16x16x32_bf16(wf[eb][1], b1, c, 0, 0, 0);
                    const f32x4 sv = *(const f32x4*)(pool_scale + g * 64 + 16 * eb + 4 * fq); acc[tb][eb] = c * sv; }
                float sq = 0.f;
#pragma unroll
                for (int eb = 0; eb < 4; ++eb) sq += (acc[tb][eb][0] * acc[tb][eb][0] + acc[tb][eb][1] * acc[tb][eb][1]) + (acc[tb][eb][2] * acc[tb][eb][2] + acc[tb][eb][3] * acc[tb][eb][3]);
                sq += __shfl_xor(sq, 16); sq += __shfl_xor(sq, 32);
                if (fq == 0) SSP[(32 * th + 16 * tb + fr) * 4 + g] = sq;
            }
            __syncthreads();
#pragma unroll
            for (int tb = 0; tb < 2; ++tb) { const int tok = 32 * th + 16 * tb + fr; const f32x4 pp = *(const LAS f32x4*)(SSP + tok * 4);
                const float r = 1.f / sqrtf(((pp[0] + pp[1]) + (pp[2] + pp[3])) * (1.f / PW) + EPS);
                bf16* op = MIXb + (size_t)(m0 + tok) * DM + g * 64 + 4 * fq;
#pragma unroll
                for (int eb = 0; eb < 4; ++eb) { const f32x4 v = acc[tb][eb] * r; v2u w; w.x = pg8::cvt_pk_bf16(v[0], v[1]); w.y = pg8::cvt_pk_bf16(v[2], v[3]); *(v2u*)(op + 16 * eb) = w; } }
        }
        __syncthreads();
    }
#endif
    GRID_BAR();

#ifndef SKIP_P3
    {
        pg8::Gemm g{MIXb, Wt_out, M, DM, DM}; pg8::StaticOrder S; S.init(M, DM, G, bx);
        pg8::EpiOutProj E{Yb, DM, SSQ};
        pg8::gemm_phase<pg8::EpiOutProj, pg8::StaticOrder, true, true>(L, g, S, E);
    }
#endif
    GRID_BAR();

#ifndef SKIP_P4
    { int tid4 = threadIdx.x; asm volatile("" : "+v"(tid4)); const int lane = tid4 & 63;
    for (int mb = gw; mb < M; mb += 4 * NGW) {
        f32x4 y[4][4], x[4][4];
#pragma unroll
        for (int k = 0; k < 4; ++k) { const int m = mb + k * NGW; const v2u* xr = (const v2u*)(Hb + (size_t)m * DM) + lane; const v2u* yr = (const v2u*)(Yb + (size_t)m * DM) + lane;
#pragma unroll
            for (int j = 0; j < 4; ++j) { const v2u w = __builtin_nontemporal_load(yr + 64 * j); y[k][j] = (f32x4){bflo(w.x), bfhi(w.x), bflo(w.y), bfhi(w.y)}; const v2u xw = __builtin_nontemporal_load(xr + 64 * j); x[k][j] = (f32x4){bflo(xw.x), bfhi(xw.x), bflo(xw.y), bfhi(xw.y)}; } }
#pragma unroll
        for (int k = 0; k < 4; ++k) { const int m = mb + k * NGW; float s = 0.f;
#pragma unroll
            for (int j = 0; j < 4; ++j) s += (y[k][j].x * y[k][j].x + y[k][j].y * y[k][j].y) + (y[k][j].z * y[k][j].z + y[k][j].w * y[k][j].w);
            const float r = 1.f / sqrtf(wave_sum(s) * (1.f / DM) + EPS);
            float s2 = 0.f;
            unsigned long long* x1row = (unsigned long long*)(X1b + (size_t)m * DM) + lane;
#pragma unroll
            for (int j = 0; j < 4; ++j) { const f32x4 gv = ((const f32x4*)g_mix_post)[64 * j + lane]; x[k][j] = x[k][j] + y[k][j] * r * gv;
                x1row[64 * j] = (unsigned long long)pk2(x[k][j].x, x[k][j].y) | ((unsigned long long)pk2(x[k][j].z, x[k][j].w) << 32);
                s2 += (x[k][j].x * x[k][j].x + x[k][j].y * x[k][j].y) + (x[k][j].z * x[k][j].z + x[k][j].w * x[k][j].w); }
            const float r2 = 1.f / sqrtf(wave_sum(s2) * (1.f / DM) + EPS);
            if (lane == 0) RS2[m] = r2; }
    } }
#endif
    GRID_BAR();

#ifndef SKIP_P567
    {
        pg8::Gemm g{X1b, Wt_up, pg8::EpiConvGelu::NTILES * 256, NUP, DM}; pg8::StaticOrder S; S.init(pg8::EpiConvGelu::NTILES * 256, NUP, G, bx);
        pg8::EpiConvGelu E{ACTb, conv_w, conv_b, RS2};
        pg8::gemm_phase<pg8::EpiConvGelu, pg8::StaticOrder, true, true>(L, g, S, E);
    }
    GRID_BAR();
    {
        pg8::Gemm g{ACTb, Wt_dn, M, DM, DFF}; pg8::StaticOrder S; S.init(M, DM, G, bx);
        pg8::EpiStore E{Zb, DM};
        pg8::gemm_phase<pg8::EpiStore, pg8::StaticOrder, true, true>(L, g, S, E);
    }
    GRID_BAR();
#endif
#ifndef SKIP_P8
    { int tid8 = threadIdx.x; asm volatile("" : "+v"(tid8)); const int lane = tid8 & 63;
    for (int mb = gw; mb < M; mb += 4 * NGW) {
        f32x4 z[4][4], x1[4][4];
#pragma unroll
        for (int k = 0; k < 4; ++k) { const int m = mb + k * NGW; const v2u* zr = (const v2u*)(Zb + (size_t)m * DM) + lane; const v2u* x1r = (const v2u*)(X1b + (size_t)m * DM) + lane;
#pragma unroll
            for (int j = 0; j < 4; ++j) { const v2u w = __builtin_nontemporal_load(zr + 64 * j); z[k][j] = (f32x4){bflo(w.x), bfhi(w.x), bflo(w.y), bfhi(w.y)}; const v2u xw = __builtin_nontemporal_load(x1r + 64 * j); x1[k][j] = (f32x4){bflo(xw.x), bfhi(xw.x), bflo(xw.y), bfhi(xw.y)}; } }
#pragma unroll
        for (int k = 0; k < 4; ++k) { const int m = mb + k * NGW; float s = 0.f;
#pragma unroll
            for (int j = 0; j < 4; ++j) s += (z[k][j].x * z[k][j].x + z[k][j].y * z[k][j].y) + (z[k][j].z * z[k][j].z + z[k][j].w * z[k][j].w);
            const float r = 1.f / sqrtf(wave_sum(s) * (1.f / DM) + EPS);
            f32x4* orow = (f32x4*)(out + (size_t)m * DM) + lane;
#pragma unroll
            for (int j = 0; j < 4; ++j) { const f32x4 gv = ((const f32x4*)g_ffn_post)[64 * j + lane]; __builtin_nontemporal_store(x1[k][j] + z[k][j] * r * gv, orow + 64 * j); } }
    } }
#endif
}

#undef out
#undef ws
#undef rope
extern "C" void kernel_launch(void* const* d_in, const int* in_sizes, int n_in, void* d_out, int out_size, void* d_ws, size_t ws_size, hipStream_t stream) {
    static int grid = 0;
    if (grid == 0) {
        if (n_in != 16 || out_size != M * DM || ws_size < WS_END) { fprintf(stderr, "kernel_launch: unexpected shapes (n_in %d out %d ws %zu)\n", n_in, out_size, ws_size); grid = -1; return; }
        int dev = 0, cus = 0, per_cu = 0;
        hipGetDevice(&dev); hipDeviceGetAttribute(&cus, hipDeviceAttributeMultiprocessorCount, dev);
        hipFuncSetAttribute((const void*)hymba_fwd, hipFuncAttributeMaxDynamicSharedMemorySize, LDS_BYTES);
        hipOccupancyMaxActiveBlocksPerMultiprocessor(&per_cu, (const void*)hymba_fwd, NTHR, LDS_BYTES);
        (void)hipGetLastError();
        if (per_cu < 1) per_cu = 1;
        grid = cus;
    }
    if (grid < 0) return;
    hipMemsetAsync((char*)d_ws + WS_CTL, 0, CTL_ZERO_BYTES, stream);
    Args a{};
    for (int i = 0; i < 16; ++i) a.in[i] = (const float*)d_in[i];
    a.out = (float*)d_out; a.ws = (unsigned char*)d_ws;
    void* kargs[] = {&a};
    hipError_t e = hipLaunchCooperativeKernel((const void*)hymba_fwd, dim3(grid), dim3(NTHR), kargs, LDS_BYTES, stream);
    if (e != hipSuccess) fprintf(stderr, "cooperative launch failed: %s (grid %d)\n", hipGetErrorString(e), grid);
}
```
